# Optimizing an MI355X kernel written in HIP

```python
import jax, jax.numpy as jnp
from jax import lax
import numpy as np

D_MODEL = 1024
BATCH = 8
SEQ = 2048
DEPTH = 2

MEM_LEN = 256
POOL_WIDTH = 512
POOL_GROUPS = 4
POOL_GROUP_DIM = POOL_WIDTH // POOL_GROUPS
POOL_WINDOWS = (2, 4, 8, 16)
MEM_HEADS = 4
MEM_HEAD_DIM = 128
MEM_WIDTH = MEM_HEADS * MEM_HEAD_DIM
RWKV_HEAD_DIM = 64
RWKV_WIDTH = D_MODEL
RWKV_HEADS = RWKV_WIDTH // RWKV_HEAD_DIM
DECAY_LORA = 64
ICLR_LORA = 64
VRES_LORA = 32
GATE_LORA = 128
RWKV_COLS = 3 * RWKV_WIDTH + DECAY_LORA + ICLR_LORA + GATE_LORA
N_BRANCH = 3
OFF_Q = POOL_WIDTH
OFF_RWKV = OFF_Q + MEM_WIDTH
OFF_GATE = OFF_RWKV + RWKV_COLS
IN_COLS = OFF_GATE + N_BRANCH * D_MODEL
D_FF = 2816
CONV_WIDTH = 3
NORM_EPS = 1e-6
LNX_EPS = 64e-5
L2_EPS = 1e-12

kernel_name = "hybrid_pool_rwkv7_memxattn_convffn"


def rms_norm(x, g):
    xf = x.astype(jnp.float32)
    y = xf * lax.rsqrt(jnp.mean(xf * xf, axis=-1, keepdims=True) + NORM_EPS)
    return (y * g.astype(jnp.float32)).astype(x.dtype)


def token_shift(z):
    return jnp.pad(z, ((0, 0), (1, 0), (0, 0)))[:, :-1]


def pool_branch(zp, pool_w, pool_b, pool_scale):
    B, S, _ = zp.shape
    p = zp.astype(jnp.float32).reshape(B, S, POOL_GROUPS, POOL_GROUP_DIM)
    cs = jnp.cumsum(p, axis=1)
    t = jnp.arange(S)
    outs = []
    for gi, win in enumerate(POOL_WINDOWS):
        c = cs[:, :, gi]
        c_lag = jnp.pad(c, ((0, 0), (win, 0), (0, 0)))[:, :S]
        cnt = jnp.minimum(t + 1, win).astype(jnp.float32)[None, :, None]
        outs.append((c - c_lag) / cnt - p[:, :, gi])
    pooled = jnp.stack(outs, axis=2).astype(zp.dtype)
    mixed = jnp.einsum('bsgc,gcd->bsgd', pooled, pool_w).reshape(B, S, POOL_WIDTH) + pool_b
    return mixed * pool_scale


def mem_attention(zq, mem_n, w_mem_kv):
    B, S, _ = zq.shape
    M = mem_n.shape[1]
    q = zq.reshape(B, S, MEM_HEADS, MEM_HEAD_DIM)
    kv = mem_n @ w_mem_kv
    k, v = jnp.split(kv, 2, axis=-1)
    k = k.reshape(B, M, MEM_HEADS, MEM_HEAD_DIM)
    v = v.reshape(B, M, MEM_HEADS, MEM_HEAD_DIM)
    s = jnp.einsum('bshd,bmhd->bhsm', q, k).astype(jnp.float32) * (MEM_HEAD_DIM ** -0.5)
    pr = jax.nn.softmax(s, axis=-1).astype(zq.dtype)
    o = jnp.einsum('bhsm,bmhd->bshd', pr, v)
    return o.reshape(B, S, MEM_WIDTH)


def rwkv7_scan(r, w, k, v, kk_neg, kk_a):
    B, _, H, N = r.shape

    def step(state, inp):
        rt, wt, kt, vt, an, bn = inp
        sa = jnp.einsum('bhvk,bhk->bhv', state, an)
        state = state * wt[:, :, None, :] + sa[..., None] * bn[:, :, None, :] + vt[..., None] * kt[:, :, None, :]
        yt = jnp.einsum('bhvk,bhk->bhv', state, rt)
        return state, yt

    xs = tuple(jnp.moveaxis(a, 1, 0) for a in (r, w, k, v, kk_neg, kk_a))
    s0 = jnp.zeros((B, H, N, N), jnp.float32)
    _, ys = lax.scan(step, s0, xs)
    return jnp.moveaxis(ys, 0, 1)


def rwkv_branch(r, k, v, dw, da, dg, w0, w_up_decay, a0, w_up_a, w_up_g, k_k, k_a, r_k, ln_x_w, ln_x_b):
    B, S, _ = r.shape
    dt = r.dtype
    f32 = jnp.float32
    w_log = -jax.nn.softplus(-(w0 + jnp.tanh(dw) @ w_up_decay).astype(f32)) - 0.5
    decay = jnp.exp(-jnp.exp(w_log))
    a = jax.nn.sigmoid((a0 + da @ w_up_a).astype(f32))
    g = jax.nn.sigmoid(dg) @ w_up_g
    hs = (B, S, RWKV_HEADS, RWKV_HEAD_DIM)
    kk = (k * k_k).astype(f32).reshape(hs)
    kk = kk * lax.rsqrt(jnp.sum(kk * kk, axis=-1, keepdims=True) + L2_EPS)
    k_eff = k.astype(f32) * (1.0 + (a - 1.0) * k_a.astype(f32))
    rh = r.astype(f32).reshape(hs)
    kh = k_eff.reshape(hs)
    vh = v.astype(f32).reshape(hs)
    wh = decay.reshape(hs)
    ah = a.reshape(hs)
    y = rwkv7_scan(rh, wh, kh, vh, -kk, kk * ah)
    mu = jnp.mean(y, axis=-1, keepdims=True)
    var = jnp.mean(jnp.square(y - mu), axis=-1, keepdims=True)
    y = ((y - mu) * lax.rsqrt(var + LNX_EPS)).reshape(B, S, RWKV_WIDTH)
    y = y * ln_x_w.astype(f32) + ln_x_b.astype(f32)
    bonus = jnp.sum(rh * kh * r_k.astype(f32), axis=-1, keepdims=True) * vh
    y = y + bonus.reshape(B, S, RWKV_WIDTH)
    return y.astype(dt) * g


def causal_dwconv(u, w, b):
    S = u.shape[1]
    up = jnp.pad(u, ((0, 0), (CONV_WIDTH - 1, 0), (0, 0)))
    out = b
    for j in range(CONV_WIDTH):
        out = out + w[j] * up[:, j:j + S]
    return out


def setup_inputs(seed: int = 0) -> dict:
    key = jax.random.key(seed)
    ks = iter(jax.random.split(key, 40))
    f32 = jnp.float32

    def nrm(shape, scale):
        return jax.random.normal(next(ks), shape, f32) * scale

    def gain(shape):
        return 1.0 + nrm(shape, 0.05)

    L, D = DEPTH, D_MODEL
    return {
        "x": nrm((BATCH, SEQ, D), 1.0),
        "mem": nrm((BATCH, MEM_LEN, D), 1.0),
        "mem_norm": gain((D,)),
        "norm_mix_pre": gain((L, D)),
        "norm_mix_post": gain((L, D)),
        "w_in": nrm((L, D, IN_COLS), D ** -0.5),
        "mu_shift": jax.random.uniform(next(ks), (L, RWKV_COLS), f32, 0.1, 0.9),
        "pool_w": nrm((L, POOL_GROUPS, POOL_GROUP_DIM, POOL_GROUP_DIM), POOL_GROUP_DIM ** -0.5),
        "pool_b": nrm((L, POOL_WIDTH), 0.01),
        "pool_scale": 1.0 + nrm((L, POOL_WIDTH), 0.1),
        "w_proj_pool": nrm((L, POOL_WIDTH, D), POOL_WIDTH ** -0.5),
        "w_mem_kv": nrm((L, D, 2 * MEM_WIDTH), D ** -0.5),
        "w_proj_mem": nrm((L, MEM_WIDTH, D), MEM_WIDTH ** -0.5),
        "w0": jax.random.uniform(next(ks), (L, RWKV_WIDTH), f32, -5.0, 1.0),
        "w_up_decay": nrm((L, DECAY_LORA, RWKV_WIDTH), DECAY_LORA ** -0.5),
        "a0": nrm((L, RWKV_WIDTH), 0.1),
        "w_up_a": nrm((L, ICLR_LORA, RWKV_WIDTH), ICLR_LORA ** -0.5),
        "w_up_g": nrm((L, GATE_LORA, RWKV_WIDTH), GATE_LORA ** -0.5),
        "k_k": 0.85 + nrm((L, RWKV_WIDTH), 0.05),
        "k_a": 1.0 + nrm((L, RWKV_WIDTH), 0.05),
        "r_k": nrm((L, RWKV_HEADS, RWKV_HEAD_DIM), 0.1),
        "ln_x_w": gain((L, RWKV_WIDTH)),
        "ln_x_b": nrm((L, RWKV_WIDTH), 0.01),
        "v0": nrm((L - 1, RWKV_WIDTH), 0.1),
        "w_down_v": nrm((L - 1, RWKV_WIDTH, VRES_LORA), RWKV_WIDTH ** -0.5),
        "w_up_v": nrm((L - 1, VRES_LORA, RWKV_WIDTH), VRES_LORA ** -0.5),
        "w_proj_rwkv": nrm((L, RWKV_WIDTH, D), RWKV_WIDTH ** -0.5),
        "gate_b": nrm((L, N_BRANCH, D), 0.01),
        "w_o": nrm((L, D, D), D ** -0.5),
        "norm_ffn_pre": gain((L, D)),
        "norm_ffn_post": gain((L, D)),
        "w_ffn_up": nrm((L, D, 2 * D_FF), D ** -0.5),
        "conv_w": nrm((L, CONV_WIDTH, 2 * D_FF), CONV_WIDTH ** -0.5),
        "conv_b": nrm((L, 2 * D_FF), 0.01),
        "w_ffn_down": nrm((L, D_FF, D), D_FF ** -0.5),
    }


def reference(x, mem, mem_norm, norm_mix_pre, norm_mix_post, w_in, mu_shift, pool_w, pool_b,
              pool_scale, w_proj_pool, w_mem_kv, w_proj_mem, w0, w_up_decay, a0, w_up_a, w_up_g,
              k_k, k_a, r_k, ln_x_w, ln_x_b, v0, w_down_v, w_up_v, w_proj_rwkv, gate_b, w_o,
              norm_ffn_pre, norm_ffn_post, w_ffn_up, conv_w, conv_b, w_ffn_down):
    B, S, D = x.shape
    mem_n = rms_norm(mem, mem_norm)
    v_first = None
    for l in range(DEPTH):
        h = rms_norm(x, norm_mix_pre[l])
        z = h @ w_in[l]
        z_pool, z_q, z_rwkv, z_gate = jnp.split(z, [OFF_Q, OFF_RWKV, OFF_GATE], axis=-1)

        y_pool = pool_branch(z_pool, pool_w[l], pool_b[l], pool_scale[l]) @ w_proj_pool[l]

        y_mem = mem_attention(z_q, mem_n, w_mem_kv[l]) @ w_proj_mem[l]

        zr = z_rwkv + (token_shift(z_rwkv) - z_rwkv) * mu_shift[l]
        r, k, v, dw, da, dg = jnp.split(
            zr, [RWKV_WIDTH, 2 * RWKV_WIDTH, 3 * RWKV_WIDTH, 3 * RWKV_WIDTH + DECAY_LORA,
                 3 * RWKV_WIDTH + DECAY_LORA + ICLR_LORA], axis=-1)
        if l == 0:
            v_first = v
        else:
            vg = jax.nn.sigmoid(v0[l - 1] + (v @ w_down_v[l - 1]) @ w_up_v[l - 1])
            v = v + (v_first - v) * vg
        y_rwkv = rwkv_branch(r, k, v, dw, da, dg, w0[l], w_up_decay[l], a0[l], w_up_a[l],
                             w_up_g[l], k_k[l], k_a[l], r_k[l], ln_x_w[l], ln_x_b[l]) @ w_proj_rwkv[l]

        gates = jax.nn.sigmoid(z_gate.reshape(B, S, N_BRANCH, D) + gate_b[l])
        merged = gates[:, :, 0] * y_pool + gates[:, :, 1] * y_rwkv + gates[:, :, 2] * y_mem
        x = x + rms_norm(merged @ w_o[l], norm_mix_post[l])

        h = rms_norm(x, norm_ffn_pre[l])
        u = causal_dwconv(h @ w_ffn_up[l], conv_w[l], conv_b[l])
        u_gate, u_val = jnp.split(u, 2, axis=-1)
        f = (jax.nn.gelu(u_gate, approximate=True) * u_val) @ w_ffn_down[l]
        x = x + rms_norm(f, norm_ffn_post[l])
    return x
```

```cpp
#include <hip/hip_runtime.h>
#include <hip/hip_cooperative_groups.h>
#include <cstdio>
namespace cg = cooperative_groups;

#define LAS __attribute__((address_space(3)))
typedef unsigned short bf16_t;
typedef short bf16x8 __attribute__((ext_vector_type(8)));
typedef float f32x4 __attribute__((ext_vector_type(4)));
typedef unsigned u32x4 __attribute__((ext_vector_type(4)));
typedef unsigned u32x2 __attribute__((ext_vector_type(2)));

constexpr int D = 1024, SEQ = 2048, TH = 8192  , DFF = 2816, INC = 7424, RWC = 3328;
constexpr size_t MiB = 1u << 20;
constexpr size_t WS_W = 0;
constexpr size_t W_IN = 0, W_POOL = 14 * MiB + MiB / 2, W_PP = 15 * MiB, W_K = 16 * MiB, W_V = 17 * MiB, W_PM = 18 * MiB, W_LORA = 19 * MiB,
                 W_DOWN = 20 * MiB + MiB / 2, W_UP = 21 * MiB, W_PR = 21 * MiB + MiB / 2, W_O = 23 * MiB + MiB / 2;
constexpr size_t W_FU = 0, W_FD = 11 * MiB;
constexpr size_t WS_MEMN = 26 * MiB, WS_KMEM = 30 * MiB, WS_VT = 32 * MiB, WS_VFIRST = 34 * MiB;
constexpr size_t WS_H = 66 * MiB;
constexpr size_t WS_ZP = 82 * MiB, WS_ZQ = 90 * MiB, WS_ZR = 98 * MiB, WS_ZK = 114 * MiB, WS_ZV = 130 * MiB, WS_ZL = 146 * MiB, WS_GATES = 150 * MiB;
constexpr size_t WS_RL = 198 * MiB, WS_KL = 214 * MiB, WS_VL = 230 * MiB;
constexpr size_t WS_H2 = 17 * MiB, WS_URAW = 66 * MiB, WS_FIN = 154 * MiB, WS_F = 66 * MiB;
constexpr size_t WS_KINV = 246 * MiB;
constexpr int DYN_LDS = 163840;

struct Params {
    const float *x, *mem, *mem_norm, *norm_mix_pre, *norm_mix_post, *w_in, *mu_shift, *pool_w, *pool_b, *pool_scale, *w_proj_pool, *w_mem_kv, *w_proj_mem, *w0, *w_up_decay,
        *a0, *w_up_a, *w_up_g, *k_k, *k_a, *r_k, *ln_x_w, *ln_x_b, *v0, *w_down_v, *w_up_v, *w_proj_rwkv, *gate_b, *w_o, *norm_ffn_pre, *norm_ffn_post, *w_ffn_up, *conv_w,
        *conv_b, *w_ffn_down;
    float* out;
    unsigned char* ws;
};

__device__ __forceinline__ unsigned cvt_pk_bf16(float lo, float hi) { unsigned r; asm("v_cvt_pk_bf16_f32 %0, %1, %2" : "=v"(r) : "v"(lo), "v"(hi)); return r; }
__device__ __forceinline__ float bf_lo(unsigned w) { return __uint_as_float(w << 16); }
__device__ __forceinline__ float bf_hi(unsigned w) { return __uint_as_float(w & 0xffff0000u); }
__device__ __forceinline__ void unpack8(const u32x4 w, float (&v)[8]) {
    v[0] = bf_lo(w.x); v[1] = bf_hi(w.x); v[2] = bf_lo(w.y); v[3] = bf_hi(w.y); v[4] = bf_lo(w.z); v[5] = bf_hi(w.z); v[6] = bf_lo(w.w); v[7] = bf_hi(w.w);
}
__device__ __forceinline__ u32x4 pack8(const float (&v)[8]) { u32x4 w; w.x = cvt_pk_bf16(v[0], v[1]); w.y = cvt_pk_bf16(v[2], v[3]); w.z = cvt_pk_bf16(v[4], v[5]); w.w = cvt_pk_bf16(v[6], v[7]); return w; }
__device__ __forceinline__ unsigned pk_h2(float a, float b) { typedef _Float16 h2 __attribute__((ext_vector_type(2))); h2 h; h.x = (_Float16)a; h.y = (_Float16)b; return __builtin_bit_cast(unsigned, h); }
__device__ __forceinline__ void unpack8h(const u32x4 w, float (&v)[8]) {
    typedef _Float16 h2 __attribute__((ext_vector_type(2)));
    const unsigned w0 = w.x, w1 = w.y, w2 = w.z, w3 = w.w;
    h2 a = __builtin_bit_cast(h2, w0), b = __builtin_bit_cast(h2, w1), c = __builtin_bit_cast(h2, w2), d = __builtin_bit_cast(h2, w3);
    v[0] = (float)a.x; v[1] = (float)a.y; v[2] = (float)b.x; v[3] = (float)b.y; v[4] = (float)c.x; v[5] = (float)c.y; v[6] = (float)d.x; v[7] = (float)d.y;
}
__device__ __forceinline__ float sigmoidf_(float x) { return __builtin_amdgcn_rcpf(1.0f + __expf(-x)); }
__device__ __forceinline__ float tanhf_(float x) { return 1.0f - 2.0f * __builtin_amdgcn_rcpf(1.0f + __expf(2.0f * x)); }
__device__ __forceinline__ float wave_sum(float v) {
#pragma unroll
    for (int o = 32; o >= 1; o >>= 1) v += __shfl_xor(v, o);
    return v;
}
__device__ __forceinline__ int opaque_tid() { int t = threadIdx.x; asm volatile("" : "+v"(t)); return t; }
template <int CTRL> __device__ __forceinline__ float dpp_f(float x) { return __int_as_float(__builtin_amdgcn_update_dpp(0, __float_as_int(x), CTRL, 0xF, 0xF, true)); }
__device__ __forceinline__ float row16_sum(float x) {
    x += dpp_f<0xB1>(x); x += dpp_f<0x4E>(x); x += dpp_f<0x141>(x); x += dpp_f<0x140>(x); return x;
}
__device__ __forceinline__ float sum8(float x) {
    x += dpp_f<0xB1>(x); x += dpp_f<0x4E>(x); x += dpp_f<0x141>(x); return x;
}
__device__ __forceinline__ float wave_sum_dpp(float x) {
    x = row16_sum(x);
    { const unsigned u = __float_as_uint(x); const auto r = __builtin_amdgcn_permlane16_swap(u, u, false, false); x = __uint_as_float(r[0]) + __uint_as_float(r[1]); }
    { const unsigned u = __float_as_uint(x); const auto r = __builtin_amdgcn_permlane32_swap(u, u, false, false); x = __uint_as_float(r[0]) + __uint_as_float(r[1]); }
    return x;
}

namespace pg8 {
constexpr int BM = 256, BK = 64, HALF = 128, HTB = HALF * BK * 2, STAGE_BYTES = 8 * HTB, NXCD = 8, WGM = 8;
__device__ __forceinline__ int lds_byte(int r, int c) { const int st = (r >> 4) * 2 + (c >> 5), rr = r & 15, cc = c & 31, ob = rr * 64 + cc * 2; return st * 1024 + (ob ^ (((ob >> 9) & 1) << 5)); }
__device__ __forceinline__ void stage_rc(int b, int& R, int& C) { const int st = b / 1024, sb = b % 1024, swz = sb ^ (((sb >> 9) & 1) << 5); R = (st >> 1) * 16 + swz / 64; C = (st & 1) * 32 + (swz % 64) / 2; }
__device__ __forceinline__ int perm32(int rho) { const int n = rho >> 4, i = rho & 15; return 8 * (i >> 2) + 4 * n + (i & 3); }
struct Unit { int pm, pn; };
struct Gemm { const bf16_t* A; const bf16_t* Bt; int M, N, K; };
struct StaticOrder {
    int nM, nN, nwg, G, c;
    __device__ void init(int M, int N, int G_, int c_) { nM = M / BM; nN = N / BM; nwg = nM * nN; G = G_; c = c_; }
    __device__ bool next(int i, Unit& u) const {
        const long L = (long)i * G + c; if (L >= nwg) return false;
        int wgid = (int)L; { const int q = nwg / NXCD, r = nwg % NXCD, xcd = wgid % NXCD, off = wgid / NXCD; wgid = (xcd < r ? xcd * (q + 1) : r * (q + 1) + (xcd - r) * q) + off; }
        const int nig = WGM * nN, gid = wgid / nig, fm = gid * WGM, gsz = (nM - fm) < WGM ? (nM - fm) : WGM;
        u.pm = fm + ((wgid % nig) % gsz); u.pn = (wgid % nig) / gsz; return true;
    }
};

template <class Epi>
__device__ __forceinline__ void gemm_phase(LAS unsigned char* lds, const Gemm g, const StaticOrder& S, const Epi& E) {
    const int tid = opaque_tid(), wid = __builtin_amdgcn_readfirstlane(tid >> 6), lane = tid & 63, wr = wid >> 2, wc = wid & 3, fr = lane & 15, fq = lane >> 4;
    const int K = g.K, nt = K / BK;
    unsigned voffA[2], voffB[2];
#pragma unroll
    for (int i = 0; i < 2; ++i) { int R, C; stage_rc(tid * 16 + i * 8192, R, C); const int Rb = Epi::PERM ? ((R & ~31) + perm32(R & 31)) : R;
        voffA[i] = (unsigned)(R * K + C) * 2u; voffB[i] = (unsigned)(Rb * K + C) * 2u; }
    const size_t kstep = (size_t)(BK * 2);
    const size_t hstep = (size_t)HALF * K * 2;
    const size_t tstep = 2 * hstep;
    const unsigned ldsw = (unsigned)wid * 1024u;
    const int aoff = lds_byte(wr * 64 + fr, fq * 8), boff = lds_byte(wc * 32 + fr, fq * 8);
#define PG8_SA(b, h) (((b) * 2 + (h)) * HTB)
#define PG8_SB(b, h) ((4 + (b) * 2 + (h)) * HTB)
#define PG8_STAGE(bufoff, gbase, voff) do { _Pragma("unroll") for (int _i = 0; _i < 2; ++_i) \
        __builtin_amdgcn_global_load_lds((const unsigned*)((const char*)(gbase) + (voff)[_i]), (LAS unsigned*)(lds + (bufoff) + ldsw + _i * 8192), 16, 0, 0); } while (0)
#define PG8_LDA(dst, b, h) do { _Pragma("unroll") for (int m = 0; m < 4; ++m) _Pragma("unroll") for (int k = 0; k < 2; ++k) dst[m][k] = *(const LAS bf16x8*)(lds + PG8_SA(b, h) + aoff + m * 2048 + k * 1024); } while (0)
#define PG8_LDB(dst, b, h) do { _Pragma("unroll") for (int n = 0; n < 2; ++n) _Pragma("unroll") for (int k = 0; k < 2; ++k) dst[n][k] = *(const LAS bf16x8*)(lds + PG8_SB(b, h) + boff + n * 2048 + k * 1024); } while (0)
#define PG8_MMA(ai, bj, At, Bt) do { __builtin_amdgcn_s_setprio(1); _Pragma("unroll") for (int m = 0; m < 4; ++m) _Pragma("unroll") for (int n = 0; n < 2; ++n) _Pragma("unroll") for (int k = 0; k < 2; ++k) \
        acc[ai][bj][m][n] = __builtin_amdgcn_mfma_f32_16x16x32_bf16(Bt[n][k], At[m][k], acc[ai][bj][m][n], 0, 0, 0); __builtin_amdgcn_s_setprio(0); } while (0)
#define PG8_WAIT_V(n) asm volatile("s_waitcnt vmcnt(" #n ")" ::: "memory")
#define PG8_WAIT_L(n) asm volatile("s_waitcnt lgkmcnt(" #n ")" ::: "memory")
#define PG8_BAR __builtin_amdgcn_s_barrier()
#define PG8_SCHED __builtin_amdgcn_sched_barrier(0)
    Unit cur, nxt; int ui = 0;
    if (!S.next(0, cur)) return;
    f32x4 acc[2][2][4][2];
#pragma unroll
    for (int a = 0; a < 2; ++a)
#pragma unroll
        for (int b = 0; b < 2; ++b)
#pragma unroll
            for (int m = 0; m < 4; ++m)
#pragma unroll
                for (int n = 0; n < 2; ++n) acc[a][b][m][n] = (f32x4){0.f, 0.f, 0.f, 0.f};
    bf16x8 At[4][2], B0[2][2], B1[2][2];
    const char* cA = (const char*)g.A + (size_t)cur.pm * tstep; const char* cB = (const char*)g.Bt + (size_t)cur.pn * tstep;
    PG8_STAGE(PG8_SB(0, 0), cB, voffB); PG8_STAGE(PG8_SA(0, 0), cA, voffA); PG8_STAGE(PG8_SB(0, 1), cB + hstep, voffB); PG8_STAGE(PG8_SA(0, 1), cA + hstep, voffA);
    if (wr == 1) PG8_BAR;
    PG8_WAIT_V(4); PG8_BAR;
    PG8_STAGE(PG8_SB(1, 0), cB + kstep, voffB); PG8_STAGE(PG8_SA(1, 0), cA + kstep, voffA); PG8_STAGE(PG8_SB(1, 1), cB + hstep + kstep, voffB);
    PG8_WAIT_V(6); PG8_BAR;
    for (;;) {
        const bool has_next = S.next(ui + 1, nxt);
        const char* nA = has_next ? (const char*)g.A + (size_t)nxt.pm * tstep : cA; const char* nB = has_next ? (const char*)g.Bt + (size_t)nxt.pn * tstep : cB;
        for (int t = 0; t < nt; t += 2) {
            const bool last = (t == nt - 2);
            const char* a1 = cA + (size_t)(t + 1) * kstep;
            const char* a2 = last ? nA : cA + (size_t)(t + 2) * kstep; const char* b2 = last ? nB : cB + (size_t)(t + 2) * kstep;
            const char* a3 = a2 + kstep; const char* b3 = b2 + kstep;
            PG8_LDB(B0, 0, 0); PG8_SCHED; PG8_LDA(At, 0, 0); PG8_STAGE(PG8_SA(1, 1), a1 + hstep, voffA);
            PG8_WAIT_L(8); PG8_BAR; PG8_WAIT_L(0); PG8_MMA(0, 0, At, B0); PG8_BAR; PG8_SCHED;
            PG8_LDB(B1, 0, 1); PG8_STAGE(PG8_SB(0, 0), b2, voffB);
            PG8_BAR; PG8_WAIT_L(0); PG8_MMA(0, 1, At, B1); PG8_BAR;
            PG8_LDA(At, 0, 1); PG8_STAGE(PG8_SA(0, 0), a2, voffA);
            PG8_BAR; PG8_WAIT_L(0); PG8_MMA(1, 0, At, B0); PG8_BAR; PG8_SCHED;
            PG8_STAGE(PG8_SB(0, 1), b2 + hstep, voffB);
            PG8_WAIT_V(6); PG8_BAR; PG8_MMA(1, 1, At, B1); PG8_BAR;
            PG8_LDB(B0, 1, 0); PG8_SCHED; PG8_LDA(At, 1, 0); PG8_STAGE(PG8_SA(0, 1), a2 + hstep, voffA);
            PG8_WAIT_L(8); PG8_BAR; PG8_WAIT_L(0); PG8_MMA(0, 0, At, B0); PG8_BAR; PG8_SCHED;
            PG8_LDB(B1, 1, 1); PG8_STAGE(PG8_SB(1, 0), b3, voffB);
            PG8_BAR; PG8_WAIT_L(0); PG8_MMA(0, 1, At, B1); PG8_BAR;
            PG8_LDA(At, 1, 1); PG8_STAGE(PG8_SA(1, 0), a3, voffA);
            PG8_BAR; PG8_WAIT_L(0); PG8_MMA(1, 0, At, B0); PG8_BAR; PG8_SCHED;
            PG8_STAGE(PG8_SB(1, 1), b3 + hstep, voffB);
            PG8_WAIT_V(6); PG8_BAR; PG8_MMA(1, 1, At, B1); PG8_BAR;
        }
        E(acc, cur, wr, wc, fr, fq);
        if (!has_next) break;
#pragma unroll
        for (int a = 0; a < 2; ++a)
#pragma unroll
            for (int b = 0; b < 2; ++b)
#pragma unroll
                for (int m = 0; m < 4; ++m)
#pragma unroll
                    for (int n = 0; n < 2; ++n) acc[a][b][m][n] = (f32x4){0.f, 0.f, 0.f, 0.f};
        cur = nxt; cA = nA; cB = nB; ++ui;
    }
    PG8_WAIT_V(0);
    if (wr == 0) PG8_BAR;
    PG8_BAR;
#undef PG8_SA
#undef PG8_SB
#undef PG8_STAGE
#undef PG8_LDA
#undef PG8_LDB
#undef PG8_MMA
#undef PG8_WAIT_V
#undef PG8_WAIT_L
#undef PG8_BAR
#undef PG8_SCHED
}
}

enum { EM_PLAIN = 0, EM_Z, EM_LORA, EM_POOLW, EM_VUP, EM_MERGE };
struct Epi {
    static constexpr bool PERM = true;
    int mode, ldo, sub, accum;
    bf16_t* O;
    const float* b0; const float* b1;
    const bf16_t* X0;
    __device__ __forceinline__ void operator()(const f32x4 (&acc)[2][2][4][2], const pg8::Unit& u, int wr, int wc, int fr, int fq) const {
        const int pn = u.pn;
        int act = 0, ld = ldo, cb = pn * 256; bf16_t* base = O; const float* bias = nullptr;
        if (mode == EM_Z) {
            if (pn < 2) { ld = 512; cb = pn * 256; }
            else if (pn < 4) { base = O + (WS_ZQ - WS_ZP) / 2; ld = 512; cb = (pn - 2) * 256; }
            else if (pn < 16) { base = O + (WS_ZR - WS_ZP) / 2 + (size_t)((pn - 4) >> 2) * TH * 1024; ld = 1024; cb = ((pn - 4) & 3) * 256; }
            else if (pn == 16) { base = O + (WS_ZL - WS_ZP) / 2; ld = 256; cb = 0; }
            else { base = O + (WS_GATES - WS_ZP) / 2; ld = 3072; cb = (pn - 17) * 256; act = 1; bias = b0 + cb; }
        } else if (mode == EM_LORA) {
            const int seg = pn >> 2; base = O + (size_t)seg * TH * 1024; ld = 1024; cb = (pn & 3) * 256;
            act = seg == 0 ? 3 : (seg == 1 ? 2 : 0); bias = seg == 0 ? b0 + cb : b1 + cb;
        } else if (mode == EM_POOLW) { act = 4; }
        const int row0 = u.pm * 256 + wr * 64 + fr;
        const int cw = wc * 32 + 8 * fq;
#pragma unroll
        for (int ai = 0; ai < 2; ++ai)
#pragma unroll
            for (int m = 0; m < 4; ++m) {
                const size_t row = (size_t)(row0 + ai * 128 + m * 16);
#pragma unroll
                for (int bj = 0; bj < 2; ++bj) {
                    const int cl = bj * 128 + cw;
                    const int colg = pn * 256 + cl;
                    float v[8];
#pragma unroll
                    for (int e = 0; e < 4; ++e) { v[e] = acc[ai][bj][m][0][e]; v[4 + e] = acc[ai][bj][m][1][e]; }
                    if (mode == EM_MERGE) {
                        float gt[8]; unpack8(*(const u32x4*)(X0 + row * 3072 + sub * 1024 + colg), gt);
                        bf16_t* op = O + row * 1024 + colg;
                        if (!accum) {
#pragma unroll
                            for (int e = 0; e < 8; ++e) v[e] *= gt[e];
                        } else {
                            float old[8]; unpack8(*(const u32x4*)op, old);
#pragma unroll
                            for (int e = 0; e < 8; ++e) v[e] = old[e] + gt[e] * v[e];
                        }
                        *(u32x4*)op = pack8(v);
                    } else if (mode == EM_VUP) {
                        bf16_t* op = O + row * 1024 + colg;
                        float vl[8], vf[8]; unpack8(*(const u32x4*)op, vl); unpack8(*(const u32x4*)(X0 + row * 1024 + colg), vf);
                        const f32x4 c0 = *(const f32x4*)(b0 + colg), c1 = *(const f32x4*)(b0 + colg + 4);
#pragma unroll
                        for (int e = 0; e < 8; ++e) { const float bb = e < 4 ? c0[e & 3] : c1[e & 3]; v[e] = vl[e] + (vf[e] - vl[e]) * sigmoidf_(bb + v[e]); }
                        *(u32x4*)op = pack8(v);
                    } else {
                        bf16_t* op = base + row * ld + cb + cl;
                        if (act == 4) {
                            const f32x4 c0 = *(const f32x4*)(b0 + colg), c1 = *(const f32x4*)(b0 + colg + 4), s0 = *(const f32x4*)(b1 + colg), s1 = *(const f32x4*)(b1 + colg + 4);
#pragma unroll
                            for (int e = 0; e < 8; ++e) v[e] = (v[e] + (e < 4 ? c0[e & 3] : c1[e & 3])) * (e < 4 ? s0[e & 3] : s1[e & 3]);
                            *(u32x4*)op = pack8(v);
                        } else if (act == 0) {
                            *(u32x4*)op = pack8(v);
                        } else {
                            const f32x4 c0 = *(const f32x4*)(bias + cl), c1 = *(const f32x4*)(bias + cl + 4);
#pragma unroll
                            for (int e = 0; e < 8; ++e) v[e] = sigmoidf_(v[e] + (e < 4 ? c0[e & 3] : c1[e & 3]));
                            if (act == 1) *(u32x4*)op = pack8(v);
                            else {
                                if (act == 3) {
#pragma unroll
                                    for (int e = 0; e < 8; ++e) v[e] = 1.0f - __expf(-0.6065306597f * v[e]);
                                }
                                u32x4 w; w.x = pk_h2(v[0], v[1]); w.y = pk_h2(v[2], v[3]); w.z = pk_h2(v[4], v[5]); w.w = pk_h2(v[6], v[7]);
                                *(u32x4*)op = w;
                            }
                        }
                    }
                }
            }
    }
};

__device__ __forceinline__ void run_gemm(LAS unsigned char* lds, const bf16_t* A, const bf16_t* Bt, int M, int N, int K, const Epi& E) {
    pg8::Gemm g; g.A = A; g.Bt = Bt; g.M = M; g.N = N; g.K = K;
    pg8::StaticOrder S; S.init(M, N, (int)gridDim.x, (int)blockIdx.x);
    pg8::gemm_phase<Epi>(lds, g, S, E);
}
__device__ __forceinline__ void run_gemm_on(LAS unsigned char* lds, const bf16_t* A, const bf16_t* Bt, int M, int N, int K, const Epi& E, int first, int count) {
    const int b = (int)blockIdx.x - first;
    if (b < 0 || b >= count) return;
    pg8::Gemm g; g.A = A; g.Bt = Bt; g.M = M; g.N = N; g.K = K;
    pg8::StaticOrder S; S.init(M, N, count, b);
    pg8::gemm_phase<Epi>(lds, g, S, E);
}
__device__ __forceinline__ Epi mk_epi(int mode, bf16_t* O, int ldo, const float* b0 = nullptr, const float* b1 = nullptr, const bf16_t* X0 = nullptr, int sub = 0, int accum = 0) {
    Epi e; e.mode = mode; e.ldo = ldo; e.sub = sub; e.accum = accum; e.O = O; e.b0 = b0; e.b1 = b1; e.X0 = X0; return e;
}

__device__ __forceinline__ void cvt_job(LAS float* tile, int& rot, bf16_t* dst, int dstLd, int nrows, const float* src, int srcLd, int srcK, int srcN, int k0) {
    const int tid = opaque_tid(), G = gridDim.x;
    const int tk = dstLd / 256, tn = nrows / 64, ntiles = tk * tn;
    for (int t = (int)((blockIdx.x + G - (rot % G)) % G); t < ntiles; t += G) {
        const int tn0 = (t / tk) * 64, tk0 = (t % tk) * 256;
        {
            const int kk = tid >> 4, n4 = (tid & 15) * 4, n = tn0 + n4;
            f32x4 v[8];
#pragma unroll
            for (int p = 0; p < 8; ++p) {
                const int ks = tk0 + kk + p * 32 - k0;
                v[p] = (f32x4){0.f, 0.f, 0.f, 0.f};
                if (ks >= 0 && ks < srcK && n < srcN) v[p] = *(const f32x4*)(src + (size_t)ks * srcLd + n);
            }
#pragma unroll
            for (int p = 0; p < 8; ++p) { const int kl = kk + p * 32; tile[kl * 65 + n4 + 0] = v[p][0]; tile[kl * 65 + n4 + 1] = v[p][1]; tile[kl * 65 + n4 + 2] = v[p][2]; tile[kl * 65 + n4 + 3] = v[p][3]; }
        }
        __syncthreads();
        {
            const int n = tid >> 3;
#pragma unroll
            for (int p = 0; p < 4; ++p) {
                const int k8 = (tid & 7) * 8 + p * 64;
                float v[8];
#pragma unroll
                for (int e = 0; e < 8; ++e) v[e] = tile[(k8 + e) * 65 + n];
                *(u32x4*)(dst + (size_t)(tn0 + n) * dstLd + tk0 + k8) = pack8(v);
            }
        }
        __syncthreads();
    }
    rot += ntiles;
}

__device__ __forceinline__ void cvt_mixer(LAS unsigned char* lds, const Params& p, int l) {
    LAS float* tile = (LAS float*)lds; int rot = 0; size_t wo = WS_W; asm volatile("" : "+s"(wo)); unsigned char* W = p.ws + wo;
    cvt_job(tile, rot, (bf16_t*)(W + W_IN), 1024, INC, p.w_in + (size_t)l * 1024 * INC, INC, 1024, INC, 0);
    for (int g = 0; g < 4; ++g) cvt_job(tile, rot, (bf16_t*)(W + W_POOL) + (size_t)g * 128 * 512, 512, 128, p.pool_w + ((size_t)l * 4 + g) * 128 * 128, 128, 128, 128, g * 128);
    cvt_job(tile, rot, (bf16_t*)(W + W_PP), 512, 1024, p.w_proj_pool + (size_t)l * 512 * 1024, 1024, 512, 1024, 0);
    cvt_job(tile, rot, (bf16_t*)(W + W_K), 1024, 512, p.w_mem_kv + (size_t)l * 1024 * 1024, 1024, 1024, 512, 0);
    cvt_job(tile, rot, (bf16_t*)(W + W_V), 1024, 512, p.w_mem_kv + (size_t)l * 1024 * 1024 + 512, 1024, 1024, 512, 0);
    cvt_job(tile, rot, (bf16_t*)(W + W_PM), 512, 1024, p.w_proj_mem + (size_t)l * 512 * 1024, 1024, 512, 1024, 0);
    cvt_job(tile, rot, (bf16_t*)(W + W_LORA), 256, 1024, p.w_up_decay + (size_t)l * 64 * 1024, 1024, 64, 1024, 0);
    cvt_job(tile, rot, (bf16_t*)(W + W_LORA) + (size_t)1024 * 256, 256, 1024, p.w_up_a + (size_t)l * 64 * 1024, 1024, 64, 1024, 64);
    cvt_job(tile, rot, (bf16_t*)(W + W_LORA) + (size_t)2048 * 256, 256, 1024, p.w_up_g + (size_t)l * 128 * 1024, 1024, 128, 1024, 128);
    if (l > 0) {
        cvt_job(tile, rot, (bf16_t*)(W + W_DOWN), 1024, 256, p.w_down_v + (size_t)(l - 1) * 1024 * 32, 32, 1024, 32, 0);
        cvt_job(tile, rot, (bf16_t*)(W + W_UP), 256, 1024, p.w_up_v + (size_t)(l - 1) * 32 * 1024, 1024, 32, 1024, 0);
    }
    cvt_job(tile, rot, (bf16_t*)(W + W_PR), 1024, 1024, p.w_proj_rwkv + (size_t)l * 1024 * 1024, 1024, 1024, 1024, 0);
    cvt_job(tile, rot, (bf16_t*)(W + W_O), 1024, 1024, p.w_o + (size_t)l * 1024 * 1024, 1024, 1024, 1024, 0);
}
__device__ __forceinline__ void cvt_ffn(LAS unsigned char* lds, const Params& p, int l) {
    LAS float* tile = (LAS float*)lds; int rot = 0; size_t wo = WS_W; asm volatile("" : "+s"(wo)); unsigned char* W = p.ws + wo;
    cvt_job(tile, rot, (bf16_t*)(W + W_FU), 1024, 2 * DFF, p.w_ffn_up + (size_t)l * 1024 * 2 * DFF, 2 * DFF, 1024, 2 * DFF, 0);
    cvt_job(tile, rot, (bf16_t*)(W + W_FD), DFF, 1024, p.w_ffn_down + (size_t)l * DFF * 1024, 1024, DFF, 1024, 0);
}

__device__ __forceinline__ void row_phase(const float* xin, const bf16_t* y, const float* gpost, float* xout, const float* gpre, bf16_t* hout, int rows, const bf16_t* y2 = nullptr) {
    const int tid_ = opaque_tid(); const int wid = tid_ >> 6, lane = tid_ & 63;
    for (int r = blockIdx.x * 8 + wid; r < rows; r += gridDim.x * 8) {
        f32x4 x[4];
#pragma unroll
        for (int i = 0; i < 4; ++i) x[i] = *(const f32x4*)(xin + (size_t)r * D + i * 256 + lane * 4);
        if (y) {
            float yv[4][4]; float ss = 0.f;
#pragma unroll
            for (int i = 0; i < 4; ++i) { const u32x2 w = *(const u32x2*)(y + (size_t)r * D + i * 256 + lane * 4);
                yv[i][0] = bf_lo(w.x); yv[i][1] = bf_hi(w.x); yv[i][2] = bf_lo(w.y); yv[i][3] = bf_hi(w.y);
                if (y2) { const u32x2 w2 = *(const u32x2*)(y2 + (size_t)r * D + i * 256 + lane * 4); yv[i][0] += bf_lo(w2.x); yv[i][1] += bf_hi(w2.x); yv[i][2] += bf_lo(w2.y); yv[i][3] += bf_hi(w2.y); }
#pragma unroll
                for (int e = 0; e < 4; ++e) ss += yv[i][e] * yv[i][e]; }
            ss = wave_sum_dpp(ss);
            const float rs = rsqrtf(ss * (1.0f / D) + 1e-6f);
#pragma unroll
            for (int i = 0; i < 4; ++i) { const f32x4 g = *(const f32x4*)(gpost + i * 256 + lane * 4);
#pragma unroll
                for (int e = 0; e < 4; ++e) x[i][e] += yv[i][e] * rs * g[e];
                *(f32x4*)(xout + (size_t)r * D + i * 256 + lane * 4) = x[i]; }
        }
        if (hout) {
            float ss = 0.f;
#pragma unroll
            for (int i = 0; i < 4; ++i)
#pragma unroll
                for (int e = 0; e < 4; ++e) ss += x[i][e] * x[i][e];
            ss = wave_sum_dpp(ss);
            const float rs = rsqrtf(ss * (1.0f / D) + 1e-6f);
#pragma unroll
            for (int i = 0; i < 4; ++i) { const f32x4 g = *(const f32x4*)(gpre + i * 256 + lane * 4);
                u32x2 w; w.x = cvt_pk_bf16(x[i][0] * rs * g[0], x[i][1] * rs * g[1]); w.y = cvt_pk_bf16(x[i][2] * rs * g[2], x[i][3] * rs * g[3]);
                *(u32x2*)(hout + (size_t)r * D + i * 256 + lane * 4) = w; }
        }
    }
}

__device__ __forceinline__ void pool_phase(const bf16_t* zp, bf16_t* pooled) {
    const size_t total = (size_t)TH * 64, stride = (size_t)gridDim.x * 512;
    for (size_t i = (size_t)blockIdx.x * 512 + opaque_tid(); i < total; i += stride) {
        const int tok = (int)(i >> 6), c8 = (int)(i & 63), t = tok & (SEQ - 1);
        const int win = 2 << (c8 >> 4); const int n = (t + 1) < win ? (t + 1) : win;
        float s[8], self[8];
        unpack8(*(const u32x4*)(zp + (size_t)tok * 512 + c8 * 8), self);
#pragma unroll
        for (int e = 0; e < 8; ++e) s[e] = self[e];
        for (int j = 1; j < n; ++j) { float v[8]; unpack8(*(const u32x4*)(zp + (size_t)(tok - j) * 512 + c8 * 8), v);
#pragma unroll
            for (int e = 0; e < 8; ++e) s[e] += v[e]; }
        const float inv = 1.0f / (float)n;
#pragma unroll
        for (int e = 0; e < 8; ++e) s[e] = s[e] * inv - self[e];
        *(u32x4*)(pooled + (size_t)tok * 512 + c8 * 8) = pack8(s);
    }
}

__device__ __forceinline__ void prep_phase(const bf16_t* zrkv  , const bf16_t* zl, const float* mu, bf16_t* rl, bf16_t* kl, bf16_t* vl, bf16_t* Al, const float* k_k, float* kinv) {
    constexpr int STRIP = 32;
    const int items = 416 * (TH / STRIP), stride = (int)gridDim.x * 512;
    for (int it = (int)blockIdx.x * 512 + opaque_tid(); it < items; it += stride) {
        const int ci = it % 416, strip = it / 416, c = ci * 8, tok0 = strip * STRIP, t0 = tok0 & (SEQ - 1);
        const bf16_t* src; bf16_t* dst; int ld;
        if (c < 3072) { const int arr = c >> 10, cc = c & 1023; src = zrkv + (size_t)arr * TH * 1024 + cc; ld = 1024; dst = (arr == 0 ? rl : (arr == 1 ? kl : vl)) + cc; }
        else { src = zl + (c - 3072); ld = 256; dst = Al + (c - 3072); }
        const bool isk = c >= 1024 && c < 2048; const int cc = isk ? c - 1024 : 0, cl = c - 3072;
        float m[8], kq[8];
        { const f32x4 m0 = *(const f32x4*)(mu + c), m1 = *(const f32x4*)(mu + c + 4), q0 = *(const f32x4*)(k_k + cc), q1 = *(const f32x4*)(k_k + cc + 4);
#pragma unroll
          for (int e = 0; e < 4; ++e) { m[e] = m0[e]; m[4 + e] = m1[e]; kq[e] = q0[e]; kq[4 + e] = q1[e]; } }
        float zp[8];
        if (t0 > 0) unpack8(*(const u32x4*)(src + (size_t)(tok0 - 1) * ld), zp);
        else {
#pragma unroll
            for (int e = 0; e < 8; ++e) zp[e] = 0.f;
        }
#pragma unroll 4
        for (int i = 0; i < STRIP; ++i) {
            const size_t tok = (size_t)(tok0 + i);
            float z[8], o[8];
            unpack8(*(const u32x4*)(src + tok * ld), z);
            float ss = 0.f;
#pragma unroll
            for (int e = 0; e < 8; ++e) { o[e] = z[e] + (zp[e] - z[e]) * m[e]; zp[e] = z[e]; const float kk = o[e] * kq[e]; ss += kk * kk; }
            ss = sum8(ss);
            if (isk && (ci & 7) == 0) kinv[tok * 16 + (cc >> 6)] = rsqrtf(ss + 1e-12f);
            if (cl >= 0) {
                if (cl < 64) {
#pragma unroll
                    for (int e = 0; e < 8; ++e) o[e] = tanhf_(o[e]);
                } else if (cl >= 128) {
#pragma unroll
                    for (int e = 0; e < 8; ++e) o[e] = sigmoidf_(o[e]);
                }
            }
            *(u32x4*)(dst + tok * ld) = pack8(o);
        }
    }
}

__device__ __forceinline__ void attn_phase(LAS unsigned char* lds, bf16_t* zq, const bf16_t* Kmem, const bf16_t* Vt, int half) {
    LAS bf16_t* Ks = (LAS bf16_t*)lds;
    LAS bf16_t* Vs = (LAS bf16_t*)(lds + 256 * 136 * 2);
    const int tid = opaque_tid(), wid = tid >> 6, lane = tid & 63, fr = lane & 15, fq = lane >> 4;
    for (int item = blockIdx.x; item < 256; item += gridDim.x) {
        const int bl = item >> 6, h = (item >> 4) & 3, qt = item & 15, gb = half * 4 + bl;
#pragma unroll
        for (int i = 0; i < 8; ++i) { const int ch = tid + i * 512, m = ch >> 4, d8 = (ch & 15) * 8;
            *(LAS u32x4*)(Ks + m * 136 + d8) = *(const u32x4*)(Kmem + (size_t)(gb * 256 + m) * 512 + h * 128 + d8); }
#pragma unroll
        for (int i = 0; i < 8; ++i) { const int ch = tid + i * 512, d = ch >> 5, m8 = (ch & 31) * 8;
            *(LAS u32x4*)(Vs + d * 264 + m8) = *(const u32x4*)(Vt + (size_t)(h * 128 + d) * 2048 + gb * 256 + m8); }
        __syncthreads();
        const size_t tok = (size_t)bl * SEQ + qt * 128 + wid * 16 + fr;
        bf16_t* qp = zq + tok * 512 + h * 128;
        bf16x8 q[4];
#pragma unroll
        for (int ks = 0; ks < 4; ++ks) q[ks] = *(const bf16x8*)(qp + ks * 32 + fq * 8);
        f32x4 sacc[16];
#pragma unroll
        for (int n = 0; n < 16; ++n) sacc[n] = (f32x4){0.f, 0.f, 0.f, 0.f};
#pragma unroll
        for (int n = 0; n < 16; ++n)
#pragma unroll
            for (int ks = 0; ks < 4; ++ks) { const bf16x8 kf = *(const LAS bf16x8*)(Ks + (16 * n + fr) * 136 + ks * 32 + fq * 8);
                sacc[n] = __builtin_amdgcn_mfma_f32_16x16x32_bf16(kf, q[ks], sacc[n], 0, 0, 0); }
        float mx = -3.0e38f;
#pragma unroll
        for (int n = 0; n < 16; ++n)
#pragma unroll
            for (int e = 0; e < 4; ++e) mx = fmaxf(mx, sacc[n][e]);
        mx = fmaxf(mx, __shfl_xor(mx, 16)); mx = fmaxf(mx, __shfl_xor(mx, 32));
        const float sc = 0.08838834764831845f;
        float sum = 0.f;
#pragma unroll
        for (int n = 0; n < 16; ++n)
#pragma unroll
            for (int e = 0; e < 4; ++e) { const float pz = __expf((sacc[n][e] - mx) * sc); sacc[n][e] = pz; sum += pz; }
        sum += __shfl_xor(sum, 16); sum += __shfl_xor(sum, 32);
        f32x4 oacc[8];
#pragma unroll
        for (int n = 0; n < 8; ++n) oacc[n] = (f32x4){0.f, 0.f, 0.f, 0.f};
#pragma unroll
        for (int kk = 0; kk < 8; ++kk) {
            u32x4 pw; pw.x = cvt_pk_bf16(sacc[2 * kk][0], sacc[2 * kk][1]); pw.y = cvt_pk_bf16(sacc[2 * kk][2], sacc[2 * kk][3]);
            pw.z = cvt_pk_bf16(sacc[2 * kk + 1][0], sacc[2 * kk + 1][1]); pw.w = cvt_pk_bf16(sacc[2 * kk + 1][2], sacc[2 * kk + 1][3]);
            const bf16x8 pf = __builtin_bit_cast(bf16x8, pw);
#pragma unroll
            for (int n = 0; n < 8; ++n) {
                const u32x2 v0 = *(const LAS u32x2*)(Vs + (16 * n + fr) * 264 + 32 * kk + 4 * fq), v1 = *(const LAS u32x2*)(Vs + (16 * n + fr) * 264 + 32 * kk + 16 + 4 * fq);
                u32x4 vw; vw.x = v0.x; vw.y = v0.y; vw.z = v1.x; vw.w = v1.y;
                oacc[n] = __builtin_amdgcn_mfma_f32_16x16x32_bf16(__builtin_bit_cast(bf16x8, vw), pf, oacc[n], 0, 0, 0);
            }
        }
        const float inv = 1.0f / sum;
#pragma unroll
        for (int n = 0; n < 8; ++n) { u32x2 w; w.x = cvt_pk_bf16(oacc[n][0] * inv, oacc[n][1] * inv); w.y = cvt_pk_bf16(oacc[n][2] * inv, oacc[n][3] * inv);
            *(u32x2*)(qp + 16 * n + 4 * fq) = w; }
        __syncthreads();
    }
}

struct ScanRaw { u32x2 r, k, v, om, a; float inv; };
typedef float f32x2 __attribute__((ext_vector_type(2)));
__device__ __forceinline__ void scan_bar() { asm volatile("s_waitcnt lgkmcnt(0)\n\ts_barrier" ::: "memory"); }
__device__ __forceinline__ void unpack4(const u32x2 w, float (&v)[4]) { v[0] = bf_lo(w.x); v[1] = bf_hi(w.x); v[2] = bf_lo(w.y); v[3] = bf_hi(w.y); }
__device__ __forceinline__ void unpack4h(const u32x2 w, float (&v)[4]) {
    typedef _Float16 h2 __attribute__((ext_vector_type(2)));
    const unsigned w0 = w.x, w1 = w.y; const h2 a = __builtin_bit_cast(h2, w0), b = __builtin_bit_cast(h2, w1);
    v[0] = (float)a.x; v[1] = (float)a.y; v[2] = (float)b.x; v[3] = (float)b.y;
}
__device__ __forceinline__ void scan_phase(LAS unsigned char* lds, const bf16_t* rl, const bf16_t* kl, const bf16_t* vl, const bf16_t* omw, const bf16_t* aa, const float* kinv, bf16_t* y, const float* k_k, const float* k_a) {
    constexpr int CH = 32, REC = 320, NC = SEQ / CH, YB = (CH / 4) * 16 * 17 * 4;
    LAS float* bufs = (LAS float*)lds;
    LAS float* yp = (LAS float*)(lds + 2 * CH * REC * 4);
    LAS float* vb = yp + 2 * YB;
    const int tid = opaque_tid();
    const bool loader = tid >= 256;
    for (int item = blockIdx.x; item < 256; item += gridDim.x) {
        const int bh = item >> 2, rg = item & 3, bl = bh >> 4, head = bh & 15;
        const size_t tok0 = (size_t)bl * SEQ; const int ch0 = head * 64;
        const int lt = tid & 255, ls = lt >> 4, cg4 = lt & 15, lc = ch0 + cg4 * 4;
        const int ys = lt >> 4, yrow = lt & 15;
        float kkc[4], kac[4];
#pragma unroll
        for (int e = 0; e < 4; ++e) { kkc[e] = k_k[lc + e]; kac[e] = k_a[lc + e]; }
        auto load_raw = [&](int chunk, int sub) { ScanRaw raw; const size_t tk = tok0 + (size_t)chunk * CH + ls + 16 * sub, idx = tk * 1024 + lc;
            raw.r = *(const u32x2*)(rl + idx); raw.k = *(const u32x2*)(kl + idx); raw.v = *(const u32x2*)(vl + idx); raw.om = *(const u32x2*)(omw + idx); raw.a = *(const u32x2*)(aa + idx);
            raw.inv = kinv[tk * 16 + head]; return raw; };
        ScanRaw rw0, rw1, rw2, rx0, rx1, rx2;
        auto prep_store = [&](LAS float* b, LAS float* vbuf, const ScanRaw& raw, int sub) {
            const int ls = (lt >> 4) + 16 * sub;
            float r[4], k[4], v[4], om[4], a[4];
            unpack4(raw.r, r); unpack4(raw.k, k); unpack4(raw.v, v); unpack4h(raw.om, om); unpack4h(raw.a, a);
            f32x4 an, w, bn, ke, rr, vv;
#pragma unroll
            for (int e = 0; e < 4; ++e) { const float kk = k[e] * (kkc[e] * raw.inv); an[e] = -kk; w[e] = 1.0f - om[e]; bn[e] = kk * a[e]; ke[e] = k[e] * (1.0f + (a[e] - 1.0f) * kac[e]); rr[e] = r[e]; vv[e] = v[e]; }
            LAS float* rec = b + ls * REC + cg4 * 4;
            *(LAS f32x4*)(rec) = an; *(LAS f32x4*)(rec + 64) = w; *(LAS f32x4*)(rec + 128) = bn; *(LAS f32x4*)(rec + 192) = ke; *(LAS f32x4*)(rec + 256) = rr;
            if ((cg4 >> 2) == rg) { LAS float* vd = vbuf + ((cg4 & 3) * 4) * CH + ls; vd[0] = vv[0]; vd[CH] = vv[1]; vd[2 * CH] = vv[2]; vd[3 * CH] = vv[3]; }
        };
        auto write_y = [&](int chunk) {
            if (lt < 16 * (CH / 4)) {
                const int g4 = lt >> 4, yrow4 = lt & 15;
                const LAS float* pp = yp + (chunk & 1) * YB + (g4 * 16 + yrow4) * 17 * 4;
                f32x4 t4 = *(const LAS f32x4*)(pp);
#pragma unroll
                for (int i = 1; i < 16; ++i) t4 += *(const LAS f32x4*)(pp + 4 * i);
                bf16_t* yd = y + (tok0 + (size_t)chunk * CH + 4 * g4) * 1024 + ch0 + rg * 16 + yrow4;
#pragma unroll
                for (int j = 0; j < 4; ++j) yd[(size_t)j * 1024] = (bf16_t)(cvt_pk_bf16(t4[j], 0.f) & 0xffffu);
            } };
        const int l = tid & 63, rloc = ((tid >> 6) & 3) * 4 + (l >> 4), c4 = (l & 15) * 4;
        f32x2 S01 = (f32x2){0.f, 0.f}, S23 = (f32x2){0.f, 0.f};

        if (loader) { rw0 = load_raw(0, 0); rx0 = load_raw(0, 1); prep_store(bufs, vb, rw0, 0); prep_store(bufs, vb, rx0, 1);
            rw0 = load_raw(1, 0); rx0 = load_raw(1, 1); rw1 = load_raw(2, 0); rx1 = load_raw(2, 1); rw2 = load_raw(3, 0); rx2 = load_raw(3, 1); }
        scan_bar();
        for (int c = 0; c < NC; ++c) {
            if (loader) {
                if (c + 1 < NC) { prep_store(bufs + ((c + 1) & 1) * (CH * REC), vb + ((c + 1) & 1) * (16 * CH), rw0, 0); prep_store(bufs + ((c + 1) & 1) * (CH * REC), vb + ((c + 1) & 1) * (16 * CH), rx0, 1); }
                rw0 = rw1; rw1 = rw2; rx0 = rx1; rx1 = rx2;
                if (c + 4 < NC) { rw2 = load_raw(c + 4, 0); rx2 = load_raw(c + 4, 1); }
                if (c >= 1) write_y(c - 1);
            } else {
                if ((tid >> 6) & 1) __builtin_amdgcn_s_sleep(1);
                LAS float* b = bufs + (c & 1) * (CH * REC);
                LAS float* yo = yp + (c & 1) * YB + (rloc * 17 + (l & 15)) * 4;
                f32x4 an = *(LAS f32x4*)(b + c4), w = *(LAS f32x4*)(b + 64 + c4), bn = *(LAS f32x4*)(b + 128 + c4), kx = *(LAS f32x4*)(b + 192 + c4), rr = *(LAS f32x4*)(b + 256 + c4);
                f32x4 v4[CH / 4];
#pragma unroll
                for (int g = 0; g < CH / 4; ++g) v4[g] = *(LAS f32x4*)(vb + (c & 1) * (16 * CH) + rloc * CH + 4 * g);
                f32x4 yq;
#pragma unroll
                for (int s = 0; s < CH; ++s) {
                    const f32x4 an_ = an, w_ = w, bn_ = bn, k_ = kx, r_ = rr; const float v_ = v4[s >> 2][s & 3];
                    if (s + 1 < CH) { LAS float* nb = b + (s + 1) * REC;
                        an = *(LAS f32x4*)(nb + c4); w = *(LAS f32x4*)(nb + 64 + c4); bn = *(LAS f32x4*)(nb + 128 + c4); kx = *(LAS f32x4*)(nb + 192 + c4); rr = *(LAS f32x4*)(nb + 256 + c4); }
                    f32x2 p2 = S01 * (f32x2){an_[0], an_[1]}; p2 = S23 * (f32x2){an_[2], an_[3]} + p2;
                    float sa = p2[0] + p2[1];
                    const f32x2 vv2 = (f32x2){v_, v_};
                    const f32x2 t01 = S01 * (f32x2){w_[0], w_[1]} + (f32x2){k_[0], k_[1]} * vv2, t23 = S23 * (f32x2){w_[2], w_[3]} + (f32x2){k_[2], k_[3]} * vv2;
                    sa = row16_sum(sa);
                    const f32x2 sa2 = (f32x2){sa, sa};
                    S01 = (f32x2){bn_[0], bn_[1]} * sa2 + t01; S23 = (f32x2){bn_[2], bn_[3]} * sa2 + t23;
                    f32x2 q2 = S01 * (f32x2){r_[0], r_[1]}; q2 = S23 * (f32x2){r_[2], r_[3]} + q2;
                    yq[s & 3] = q2[0] + q2[1];
                    if ((s & 3) == 3) *(LAS f32x4*)(yo + (s >> 2) * (16 * 17 * 4)) = yq;
                }
            }
            scan_bar();
        }
        if (loader) write_y(NC - 1);
        scan_bar();
    }
}

__device__ __forceinline__ void post_phase(bf16_t* y, const bf16_t* rl, const bf16_t* kl, const bf16_t* vl, const bf16_t* aa, const bf16_t* gg, const float* k_a, const float* r_k, const float* lnw, const float* lnb) {
    constexpr int STRIP = 8;
    const int items = 128 * (TH / STRIP), stride = (int)gridDim.x * 512;
    for (int it = (int)blockIdx.x * 512 + opaque_tid(); it < items; it += stride) {
        const int c = (it & 127) * 8; const size_t tok0 = (size_t)(it >> 7) * STRIP;
        float ka[8], rk[8], lw[8], lb[8];
        { const f32x4 a0 = *(const f32x4*)(k_a + c), a1 = *(const f32x4*)(k_a + c + 4), b0 = *(const f32x4*)(r_k + c), b1 = *(const f32x4*)(r_k + c + 4),
                      c0 = *(const f32x4*)(lnw + c), c1 = *(const f32x4*)(lnw + c + 4), d0 = *(const f32x4*)(lnb + c), d1 = *(const f32x4*)(lnb + c + 4);
#pragma unroll
          for (int e = 0; e < 4; ++e) { ka[e] = a0[e]; ka[4 + e] = a1[e]; rk[e] = b0[e]; rk[4 + e] = b1[e]; lw[e] = c0[e]; lw[4 + e] = c1[e]; lb[e] = d0[e]; lb[4 + e] = d1[e]; } }
#pragma unroll 2
        for (int i = 0; i < STRIP; ++i) {
            const size_t idx = (tok0 + i) * 1024 + c;
            float yv[8], r[8], k[8], v[8], a[8], g[8];
            unpack8(*(const u32x4*)(y + idx), yv); unpack8(*(const u32x4*)(rl + idx), r); unpack8(*(const u32x4*)(kl + idx), k); unpack8(*(const u32x4*)(vl + idx), v);
            unpack8h(*(const u32x4*)(aa + idx), a); unpack8(*(const u32x4*)(gg + idx), g);
            float s = 0.f, dot = 0.f;
#pragma unroll
            for (int e = 0; e < 8; ++e) { s += yv[e]; dot += r[e] * k[e] * (1.0f + (a[e] - 1.0f) * ka[e]) * rk[e]; }
            s = sum8(s); dot = sum8(dot);
            const float mu = s * (1.0f / 64.0f);
            float q = 0.f;
#pragma unroll
            for (int e = 0; e < 8; ++e) { const float d = yv[e] - mu; q += d * d; }
            q = sum8(q);
            const float rs = rsqrtf(q * (1.0f / 64.0f) + 64e-5f);
#pragma unroll
            for (int e = 0; e < 8; ++e) yv[e] = (((yv[e] - mu) * rs) * lw[e] + lb[e] + dot * v[e]) * g[e];
            *(u32x4*)(y + idx) = pack8(yv);
        }
    }
}

__device__ __forceinline__ void conv_phase(const bf16_t* u, bf16_t* fin, const float* cw, const float* cb) {
    constexpr int STRIP = 32;
    const int items = 352 * (TH / STRIP), stride = (int)gridDim.x * 512;
    for (int it = (int)blockIdx.x * 512 + opaque_tid(); it < items; it += stride) {
        const int chunk = it % 352, strip = it / 352, n = chunk * 8, tok0 = strip * STRIP, t0 = tok0 & (SEQ - 1);
        float wg[3][8], wv[3][8], bg[8], bv[8];
#pragma unroll
        for (int j = 0; j < 3; ++j) {
            const f32x4 a0 = *(const f32x4*)(cw + j * 2 * DFF + n), a1 = *(const f32x4*)(cw + j * 2 * DFF + n + 4), b0 = *(const f32x4*)(cw + j * 2 * DFF + DFF + n), b1 = *(const f32x4*)(cw + j * 2 * DFF + DFF + n + 4);
#pragma unroll
            for (int e = 0; e < 4; ++e) { wg[j][e] = a0[e]; wg[j][4 + e] = a1[e]; wv[j][e] = b0[e]; wv[j][4 + e] = b1[e]; }
        }
        {
            const f32x4 a0 = *(const f32x4*)(cb + n), a1 = *(const f32x4*)(cb + n + 4), b0 = *(const f32x4*)(cb + DFF + n), b1 = *(const f32x4*)(cb + DFF + n + 4);
#pragma unroll
            for (int e = 0; e < 4; ++e) { bg[e] = a0[e]; bg[4 + e] = a1[e]; bv[e] = b0[e]; bv[4 + e] = b1[e]; }
        }
        float g2[8], v2[8], g1[8], v1[8];
        if (t0 >= 2) {
            unpack8(*(const u32x4*)(u + (size_t)(tok0 - 2) * (2 * DFF) + n), g2); unpack8(*(const u32x4*)(u + (size_t)(tok0 - 2) * (2 * DFF) + DFF + n), v2);
            unpack8(*(const u32x4*)(u + (size_t)(tok0 - 1) * (2 * DFF) + n), g1); unpack8(*(const u32x4*)(u + (size_t)(tok0 - 1) * (2 * DFF) + DFF + n), v1);
        } else {
#pragma unroll
            for (int e = 0; e < 8; ++e) { g2[e] = 0.f; v2[e] = 0.f; g1[e] = 0.f; v1[e] = 0.f; }
        }
#pragma unroll 4
        for (int i = 0; i < STRIP; ++i) {
            const size_t tok = (size_t)(tok0 + i);
            float g0[8], v0[8], o[8];
            unpack8(*(const u32x4*)(u + tok * (2 * DFF) + n), g0); unpack8(*(const u32x4*)(u + tok * (2 * DFF) + DFF + n), v0);
#pragma unroll
            for (int e = 0; e < 8; ++e) {
                const float x = bg[e] + wg[0][e] * g2[e] + wg[1][e] * g1[e] + wg[2][e] * g0[e];
                const float vv = bv[e] + wv[0][e] * v2[e] + wv[1][e] * v1[e] + wv[2][e] * v0[e];
                o[e] = x * sigmoidf_(1.5957691216f * (x + 0.044715f * x * x * x)) * vv;
                g2[e] = g1[e]; g1[e] = g0[e]; v2[e] = v1[e]; v1[e] = v0[e];
            }
            *(u32x4*)(fin + tok * DFF + n) = pack8(o);
        }
    }
}

#define XB_TMO      128
#define XB_XCNT(j)  (256  + 64 * (j))
#define XB_XSUB(j)  (1280 + 64 * (j))
#define XB_XGEN(j)  (2304 + 64 * (j))
#define XB_TOP      3328
#define XB_TOPGEN   3392
#define XCD_BAR_WORDS 3456
#define XB_SPIN_CAP (1u << 18)
__device__ __forceinline__ unsigned xb_ld(unsigned* p)              { return __hip_atomic_load(p, __ATOMIC_RELAXED, __HIP_MEMORY_SCOPE_AGENT); }
__device__ __forceinline__ unsigned xb_add(unsigned* p, unsigned v) { return __hip_atomic_fetch_add(p, v, __ATOMIC_RELAXED, __HIP_MEMORY_SCOPE_AGENT); }
__device__ __forceinline__ unsigned xb_xcc_id() { return (unsigned)__builtin_amdgcn_s_getreg((3 << 11) | 20) & 0xFu; }
#define XB_SPIN(cond, bar) do { unsigned _sp = 0; while (cond) { __builtin_amdgcn_s_sleep(1); \
    if ((++_sp & 255u) == 0u) { if (xb_ld(&(bar)[XB_TMO])) break; if (_sp > XB_SPIN_CAP) { atomicAdd(&(bar)[XB_TMO], 1u); break; } } } } while (0)
struct XcdBarrier { unsigned* bar; unsigned x; volatile LAS unsigned* st; };
__device__ __forceinline__ XcdBarrier xcd_barrier_post(unsigned* bar, volatile LAS unsigned* st) {
    XcdBarrier b; b.bar = bar; b.x = xb_xcc_id(); b.st = st;
    if (threadIdx.x == 0) (void)xb_add(&bar[XB_XCNT(b.x)], 1u);
    return b;
}
__device__ __forceinline__ void xcd_barrier_complete(unsigned* bar, unsigned x, unsigned& nloc, unsigned& nx) {
    const unsigned G = gridDim.x * gridDim.y * gridDim.z;
    unsigned sum, cnt, mine, sp = 0u;
    for (;;) {
        sum = 0u; cnt = 0u; mine = 0u;
#pragma unroll
        for (unsigned j = 0; j < 16; ++j) { const unsigned c = xb_ld(&bar[XB_XCNT(j)]); sum += c; cnt += (c > 0u) ? 1u : 0u; mine = (j == x) ? c : mine; }
        if (sum == G) break;
        __builtin_amdgcn_s_sleep(1);
        if ((++sp & 255u) == 0u) { if (xb_ld(&bar[XB_TMO])) break; if (sp > XB_SPIN_CAP) { atomicAdd(&bar[XB_TMO], 1u); break; } }
    }
    nloc = mine > 0u ? mine : 1u; nx = cnt > 0u ? cnt : 1u;
}
__device__ __forceinline__ void xcd_barrier(const XcdBarrier& b) {
    asm volatile("s_waitcnt vmcnt(0)" ::: "memory");
    __syncthreads();
    if (threadIdx.x == 0) {
        unsigned* bar = b.bar;
        __builtin_amdgcn_s_waitcnt(0);
        unsigned nloc = b.st[0], nx = b.st[1];
        if (nloc == 0u) { xcd_barrier_complete(bar, b.x, nloc, nx); b.st[0] = nloc; b.st[1] = nx; }
        const unsigned old = xb_add(&bar[XB_XSUB(b.x)], 1u);
        const unsigned gen = old / nloc;
        if (old + 1u == (gen + 1u) * nloc) {
            __builtin_amdgcn_fence(__ATOMIC_RELEASE, "agent");
            asm volatile("s_waitcnt vmcnt(0)" ::: "memory");
            const unsigned og = xb_add(&bar[XB_TOP], 1u);
            const unsigned tg = og / nx;
            if (og + 1u == (tg + 1u) * nx) xb_add(&bar[XB_TOPGEN], 1u);
            else XB_SPIN(xb_ld(&bar[XB_TOPGEN]) == tg, bar);
            __builtin_amdgcn_fence(__ATOMIC_ACQUIRE, "agent");
            xb_add(&bar[XB_XGEN(b.x)], 1u);
            asm volatile("s_waitcnt vmcnt(0)" ::: "memory");
        } else {
            XB_SPIN(xb_ld(&bar[XB_XGEN(b.x)]) == gen, bar);
            __builtin_amdgcn_fence(__ATOMIC_ACQUIRE, "agent");
            asm volatile("s_waitcnt vmcnt(0)" ::: "memory");
        }
    }
    __syncthreads();
}
constexpr size_t WS_BAR = 254 * MiB;

__global__ void __launch_bounds__(512, 2) fwd_megakernel(Params p) {
    extern __shared__ __attribute__((aligned(16))) unsigned char shm[];
    LAS unsigned char* lds = (LAS unsigned char*)shm;
    cg::grid_group grid = cg::this_grid();
    volatile LAS unsigned* xst = (volatile LAS unsigned*)(lds + DYN_LDS - 16);
    if (threadIdx.x == 0) { xst[0] = 0u; xst[1] = 0u; }
    if (blockIdx.x == 0) for (int i = threadIdx.x; i < XCD_BAR_WORDS; i += 512) ((unsigned*)(p.ws + WS_BAR))[i] = 0u;
    __syncthreads();
    XcdBarrier xbar; xbar.bar = (unsigned*)(p.ws + WS_BAR); xbar.x = xb_xcc_id(); xbar.st = xst;
    auto wsp = [&](size_t off) -> bf16_t* { size_t o = off; asm volatile("" : "+s"(o)); return (bf16_t*)(p.ws + o); };
#define HBUF wsp(WS_H)
#define POOLED wsp(WS_H)
#define AL wsp(WS_H + 8 * MiB)
#define VD wsp(WS_H + 12 * MiB)
#define ZP wsp(WS_ZP)
#define ZQ wsp(WS_ZQ)
#define ZR wsp(WS_ZR)
#define ZK wsp(WS_ZK)
#define ZV wsp(WS_ZV)
#define ZL wsp(WS_ZL)
#define GATES wsp(WS_GATES)
#define RL wsp(WS_RL)
#define KL wsp(WS_KL)
#define WT(off) ((const bf16_t*)wsp(WS_W + (off)))

    for (int l = 0; l < 2; ++l) {
        row_phase(p.mem, nullptr, nullptr, nullptr, p.mem_norm, wsp(WS_MEMN), 2048);
        cvt_mixer(lds, p, l);
        row_phase(l == 0 ? p.x : p.out, nullptr, nullptr, nullptr, p.norm_mix_pre + l * D, HBUF, TH);
        if (l == 0) { grid.sync(); if (threadIdx.x == 0) (void)xb_add(&xbar.bar[XB_XCNT(xbar.x)], 1u); }
        else xcd_barrier(xbar);
        for (int hb = 0; hb < 2; ++hb) {
            const size_t xoff = (size_t)hb * TH * D;
            const float* xin = (l == 0 ? p.x : p.out) + xoff;
            const size_t vf_off = WS_VFIRST + xoff * 2, vl_off = l == 0 ? vf_off : WS_VL;
            run_gemm(lds, HBUF, WT(W_IN), TH, INC, 1024, mk_epi(EM_Z, ZP, 0, p.gate_b + (size_t)l * 3 * D));
            if (hb == 0) {
                const int G = (int)gridDim.x, nz = (TH / 256) * (INC / 256), f0 = nz % G < G - 32 ? nz % G : 0;
                run_gemm_on(lds, wsp(WS_MEMN), WT(W_K), 2048, 512, 1024, mk_epi(EM_PLAIN, wsp(WS_KMEM), 512), f0, 16);
                run_gemm_on(lds, WT(W_V), wsp(WS_MEMN), 512, 2048, 1024, mk_epi(EM_PLAIN, wsp(WS_VT), 2048), f0 + 16, G - f0 - 16);
            }
            xcd_barrier(xbar);
            pool_phase(ZP, POOLED);
            prep_phase(ZR, ZL, p.mu_shift + (size_t)l * RWC, RL, KL, wsp(vl_off), AL, p.k_k + l * D, (float*)wsp(WS_KINV));
            attn_phase(lds, ZQ, wsp(WS_KMEM), wsp(WS_VT), hb);
            xcd_barrier(xbar);
            {
                const int G = (int)gridDim.x, nv = l > 0 ? G / 8 : 0, np = G / 4, nl = G - np - nv;
                run_gemm_on(lds, AL, WT(W_LORA), TH, 3072, 256, mk_epi(EM_LORA, ZR, 1024, p.w0 + l * D, p.a0 + l * D), 0, nl);
                run_gemm_on(lds, POOLED, WT(W_POOL), TH, 512, 512, mk_epi(EM_POOLW, ZP, 512, p.pool_b + l * 512, p.pool_scale + l * 512), nl, np);
                if (l > 0) run_gemm_on(lds, wsp(vl_off), WT(W_DOWN), TH, 256, 1024, mk_epi(EM_PLAIN, VD, 256), nl + np, nv);
            }
            xcd_barrier(xbar);
            if (l > 0) {
                run_gemm(lds, VD, WT(W_UP), TH, 1024, 256, mk_epi(EM_VUP, wsp(vl_off), 1024, p.v0 + (size_t)(l - 1) * D, nullptr, wsp(vf_off)));
                xcd_barrier(xbar);
            }
            scan_phase(lds, RL, KL, wsp(vl_off), ZR  , ZK  , (const float*)wsp(WS_KINV), HBUF, p.k_k + l * D, p.k_a + l * D);
            xcd_barrier(xbar);
            post_phase(HBUF, RL, KL, wsp(vl_off), ZK  , ZV  , p.k_a + l * D, p.r_k + l * D, p.ln_x_w + l * D, p.ln_x_b + l * D);
            xcd_barrier(xbar);
            {
                const int G = (int)gridDim.x, h0 = G / 2;
                run_gemm_on(lds, ZP, WT(W_PP), TH, 1024, 512, mk_epi(EM_MERGE, ZR  , 1024, nullptr, nullptr, GATES, 0, 0), 0, h0);
                run_gemm_on(lds, ZQ, WT(W_PM), TH, 1024, 512, mk_epi(EM_MERGE, ZR, 1024, nullptr, nullptr, GATES, 2, 1), 0, h0);
                run_gemm_on(lds, HBUF, WT(W_PR), TH, 1024, 1024, mk_epi(EM_MERGE, ZV  , 1024, nullptr, nullptr, GATES, 1, 0), h0, G - h0);
                xcd_barrier(xbar);
                run_gemm_on(lds, ZR, WT(W_O), TH, 1024, 1024, mk_epi(EM_PLAIN, ZK  , 1024), 0, h0);
                run_gemm_on(lds, ZV, WT(W_O), TH, 1024, 1024, mk_epi(EM_PLAIN, RL  , 1024), h0, G - h0);
                xcd_barrier(xbar);
            }
            row_phase(xin, ZK, p.norm_mix_post + l * D, p.out + xoff, nullptr, nullptr, TH, RL);
            if (hb == 0) row_phase((l == 0 ? p.x : p.out) + (size_t)TH * D, nullptr, nullptr, nullptr, p.norm_mix_pre + l * D, HBUF, TH);
            if (hb == 1) { cvt_ffn(lds, p, l); row_phase(p.out, nullptr, nullptr, nullptr, p.norm_ffn_pre + l * D, wsp(WS_H2), TH); }
            xcd_barrier(xbar);
        }
        for (int hb = 0; hb < 2; ++hb) {
            run_gemm(lds, wsp(WS_H2), WT(W_FU), TH, 2 * DFF, 1024, mk_epi(EM_PLAIN, wsp(WS_URAW), 2 * DFF));
            xcd_barrier(xbar);
            conv_phase(wsp(WS_URAW), wsp(WS_FIN) + (size_t)hb * TH * DFF, p.conv_w + (size_t)l * 3 * 2 * DFF, p.conv_b + (size_t)l * 2 * DFF);
            if (hb == 0) row_phase(p.out + (size_t)TH * D, nullptr, nullptr, nullptr, p.norm_ffn_pre + l * D, wsp(WS_H2), TH);
            xcd_barrier(xbar);
        }
        run_gemm(lds, wsp(WS_FIN), WT(W_FD), 2 * TH, 1024, DFF, mk_epi(EM_PLAIN, wsp(WS_F), 1024));
        xcd_barrier(xbar);
        row_phase(p.out, wsp(WS_F), p.norm_ffn_post + l * D, p.out, nullptr, nullptr, 2 * TH);
        xcd_barrier(xbar);
    }
}

extern "C" void kernel_launch(void* const* d_in, const int* in_sizes, int n_in, void* d_out, int out_size, void* d_ws, size_t ws_size, hipStream_t stream) {
    static int grid_blocks = 0;
    if (!grid_blocks) {
        int dev = 0, cus = 0, per_cu = 0;
        hipGetDevice(&dev);
        hipDeviceGetAttribute(&cus, hipDeviceAttributeMultiprocessorCount, dev);
        hipFuncSetAttribute((const void*)fwd_megakernel, hipFuncAttributeMaxDynamicSharedMemorySize, DYN_LDS);
        hipOccupancyMaxActiveBlocksPerMultiprocessor(&per_cu, fwd_megakernel, 512, DYN_LDS);
        if (per_cu < 1) per_cu = 1;
        grid_blocks = cus * per_cu;
    }
    Params p{};
    const float** pp = (const float**)&p;
    for (int i = 0; i < 35; ++i) pp[i] = (const float*)d_in[i];
    p.out = (float*)d_out; p.ws = (unsigned char*)d_ws;
    void* args[] = {&p};
    hipError_t e = hipLaunchCooperativeKernel((void*)fwd_megakernel, dim3(grid_blocks), dim3(512), args, DYN_LDS, stream);
    if (e != hipSuccess) fprintf(stderr, "cooperative launch failed: %s (grid %d)\n", hipGetErrorString(e), grid_blocks);
}
```

```cpp
#include <hip/hip_runtime.h>
#include <hip/hip_cooperative_groups.h>
#include <cstdio>
namespace cg = cooperative_groups;

#define LAS __attribute__((address_space(3)))
typedef unsigned short bf16_t;
typedef short bf16x8 __attribute__((ext_vector_type(8)));
typedef float f32x4 __attribute__((ext_vector_type(4)));
typedef unsigned u32x4 __attribute__((ext_vector_type(4)));
typedef unsigned u32x2 __attribute__((ext_vector_type(2)));

constexpr int D = 1024, SEQ = 2048, TH = 8192  , DFF = 2816, INC = 7424, RWC = 3328;
constexpr size_t MiB = 1u << 20;
constexpr size_t WS_W = 0;
constexpr size_t W_IN = 0, W_POOL = 14 * MiB + MiB / 2, W_PP = 15 * MiB, W_K = 16 * MiB, W_V = 17 * MiB, W_PM = 18 * MiB, W_LORA = 19 * MiB,
                 W_DOWN = 20 * MiB + MiB / 2, W_UP = 21 * MiB, W_PR = 21 * MiB + MiB / 2, W_O = 23 * MiB + MiB / 2;
constexpr size_t W_FU = 0, W_FD = 11 * MiB;
constexpr size_t WS_MEMN = 26 * MiB, WS_KMEM = 30 * MiB, WS_VT = 32 * MiB, WS_VFIRST = 34 * MiB;
constexpr size_t WS_H = 66 * MiB;
constexpr size_t WS_ZP = 82 * MiB, WS_ZQ = 90 * MiB, WS_ZR = 98 * MiB, WS_ZK = 114 * MiB, WS_ZV = 130 * MiB, WS_ZL = 146 * MiB, WS_GATES = 150 * MiB;
constexpr size_t WS_RL = 198 * MiB, WS_KL = 214 * MiB, WS_VL = 230 * MiB;
constexpr size_t WS_H2 = 17 * MiB, WS_URAW = 66 * MiB, WS_FIN = 154 * MiB, WS_F = 66 * MiB;
constexpr size_t WS_KINV = 246 * MiB;
constexpr int DYN_LDS = 163840;

struct Params {
    const float *x, *mem, *mem_norm, *norm_mix_pre, *norm_mix_post, *w_in, *mu_shift, *pool_w, *pool_b, *pool_scale, *w_proj_pool, *w_mem_kv, *w_proj_mem, *w0, *w_up_decay,
        *a0, *w_up_a, *w_up_g, *k_k, *k_a, *r_k, *ln_x_w, *ln_x_b, *v0, *w_down_v, *w_up_v, *w_proj_rwkv, *gate_b, *w_o, *norm_ffn_pre, *norm_ffn_post, *w_ffn_up, *conv_w,
        *conv_b, *w_ffn_down;
    float* out;
    unsigned char* ws;
};

__device__ __forceinline__ unsigned cvt_pk_bf16(float lo, float hi) { unsigned r; asm("v_cvt_pk_bf16_f32 %0, %1, %2" : "=v"(r) : "v"(lo), "v"(hi)); return r; }
__device__ __forceinline__ float bf_lo(unsigned w) { return __uint_as_float(w << 16); }
__device__ __forceinline__ float bf_hi(unsigned w) { return __uint_as_float(w & 0xffff0000u); }
__device__ __forceinline__ void unpack8(const u32x4 w, float (&v)[8]) {
    v[0] = bf_lo(w.x); v[1] = bf_hi(w.x); v[2] = bf_lo(w.y); v[3] = bf_hi(w.y); v[4] = bf_lo(w.z); v[5] = bf_hi(w.z); v[6] = bf_lo(w.w); v[7] = bf_hi(w.w);
}
__device__ __forceinline__ u32x4 pack8(const float (&v)[8]) { u32x4 w; w.x = cvt_pk_bf16(v[0], v[1]); w.y = cvt_pk_bf16(v[2], v[3]); w.z = cvt_pk_bf16(v[4], v[5]); w.w = cvt_pk_bf16(v[6], v[7]); return w; }
__device__ __forceinline__ unsigned pk_h2(float a, float b) { typedef _Float16 h2 __attribute__((ext_vector_type(2))); h2 h; h.x = (_Float16)a; h.y = (_Float16)b; return __builtin_bit_cast(unsigned, h); }
__device__ __forceinline__ void unpack8h(const u32x4 w, float (&v)[8]) {
    typedef _Float16 h2 __attribute__((ext_vector_type(2)));
    const unsigned w0 = w.x, w1 = w.y, w2 = w.z, w3 = w.w;
    h2 a = __builtin_bit_cast(h2, w0), b = __builtin_bit_cast(h2, w1), c = __builtin_bit_cast(h2, w2), d = __builtin_bit_cast(h2, w3);
    v[0] = (float)a.x; v[1] = (float)a.y; v[2] = (float)b.x; v[3] = (float)b.y; v[4] = (float)c.x; v[5] = (float)c.y; v[6] = (float)d.x; v[7] = (float)d.y;
}
__device__ __forceinline__ float sigmoidf_(float x) { return __builtin_amdgcn_rcpf(1.0f + __expf(-x)); }
__device__ __forceinline__ float tanhf_(float x) { return 1.0f - 2.0f * __builtin_amdgcn_rcpf(1.0f + __expf(2.0f * x)); }
__device__ __forceinline__ float wave_sum(float v) {
#pragma unroll
    for (int o = 32; o >= 1; o >>= 1) v += __shfl_xor(v, o);
    return v;
}
__device__ __forceinline__ int opaque_tid() { int t = threadIdx.x; asm volatile("" : "+v"(t)); return t; }
template <int CTRL> __device__ __forceinline__ float dpp_f(float x) { return __int_as_float(__builtin_amdgcn_update_dpp(0, __float_as_int(x), CTRL, 0xF, 0xF, true)); }
__device__ __forceinline__ float row16_sum(float x) {
    x += dpp_f<0xB1>(x); x += dpp_f<0x4E>(x); x += dpp_f<0x141>(x); x += dpp_f<0x140>(x); return x;
}
__device__ __forceinline__ float sum8(float x) {
    x += dpp_f<0xB1>(x); x += dpp_f<0x4E>(x); x += dpp_f<0x141>(x); return x;
}
__device__ __forceinline__ float wave_sum_dpp(float x) {
    x = row16_sum(x);
    { const unsigned u = __float_as_uint(x); const auto r = __builtin_amdgcn_permlane16_swap(u, u, false, false); x = __uint_as_float(r[0]) + __uint_as_float(r[1]); }
    { const unsigned u = __float_as_uint(x); const auto r = __builtin_amdgcn_permlane32_swap(u, u, false, false); x = __uint_as_float(r[0]) + __uint_as_float(r[1]); }
    return x;
}

namespace pg8 {
constexpr int BM = 256, BK = 64, HALF = 128, HTB = HALF * BK * 2, STAGE_BYTES = 8 * HTB, NXCD = 8, WGM = 8;
__device__ __forceinline__ int lds_byte(int r, int c) { const int st = (r >> 4) * 2 + (c >> 5), rr = r & 15, cc = c & 31, ob = rr * 64 + cc * 2; return st * 1024 + (ob ^ (((ob >> 9) & 1) << 5)); }
__device__ __forceinline__ void stage_rc(int b, int& R, int& C) { const int st = b / 1024, sb = b % 1024, swz = sb ^ (((sb >> 9) & 1) << 5); R = (st >> 1) * 16 + swz / 64; C = (st & 1) * 32 + (swz % 64) / 2; }
__device__ __forceinline__ int perm32(int rho) { const int n = rho >> 4, i = rho & 15; return 8 * (i >> 2) + 4 * n + (i & 3); }
struct Unit { int pm, pn; };
struct Gemm { const bf16_t* A; const bf16_t* Bt; int M, N, K; };
struct StaticOrder {
    int nM, nN, nwg, G, c;
    __device__ void init(int M, int N, int G_, int c_) { nM = M / BM; nN = N / BM; nwg = nM * nN; G = G_; c = c_; }
    __device__ bool next(int i, Unit& u) const {
        const long L = (long)i * G + c; if (L >= nwg) return false;
        int wgid = (int)L; { const int q = nwg / NXCD, r = nwg % NXCD, xcd = wgid % NXCD, off = wgid / NXCD; wgid = (xcd < r ? xcd * (q + 1) : r * (q + 1) + (xcd - r) * q) + off; }
        const int nig = WGM * nN, gid = wgid / nig, fm = gid * WGM, gsz = (nM - fm) < WGM ? (nM - fm) : WGM;
        u.pm = fm + ((wgid % nig) % gsz); u.pn = (wgid % nig) / gsz; return true;
    }
};

template <class Epi>
__device__ __forceinline__ void gemm_phase(LAS unsigned char* lds, const Gemm g, const StaticOrder& S, const Epi& E) {
    const int tid = opaque_tid(), wid = __builtin_amdgcn_readfirstlane(tid >> 6), lane = tid & 63, wr = wid >> 2, wc = wid & 3, fr = lane & 15, fq = lane >> 4;
    const int K = g.K, nt = K / BK;
    unsigned voffA[2], voffB[2];
#pragma unroll
    for (int i = 0; i < 2; ++i) { int R, C; stage_rc(tid * 16 + i * 8192, R, C); const int Rb = Epi::PERM ? ((R & ~31) + perm32(R & 31)) : R;
        voffA[i] = (unsigned)(R * K + C) * 2u; voffB[i] = (unsigned)(Rb * K + C) * 2u; }
    const size_t kstep = (size_t)(BK * 2);
    const size_t hstep = (size_t)HALF * K * 2;
    const size_t tstep = 2 * hstep;
    const unsigned ldsw = (unsigned)wid * 1024u;
    const int aoff = lds_byte(wr * 64 + fr, fq * 8), boff = lds_byte(wc * 32 + fr, fq * 8);
#define PG8_SA(b, h) (((b) * 2 + (h)) * HTB)
#define PG8_SB(b, h) ((4 + (b) * 2 + (h)) * HTB)
#define PG8_STAGE(bufoff, gbase, voff) do { _Pragma("unroll") for (int _i = 0; _i < 2; ++_i) \
        __builtin_amdgcn_global_load_lds((const unsigned*)((const char*)(gbase) + (voff)[_i]), (LAS unsigned*)(lds + (bufoff) + ldsw + _i * 8192), 16, 0, 0); } while (0)
#define PG8_LDA(dst, b, h) do { _Pragma("unroll") for (int m = 0; m < 4; ++m) _Pragma("unroll") for (int k = 0; k < 2; ++k) dst[m][k] = *(const LAS bf16x8*)(lds + PG8_SA(b, h) + aoff + m * 2048 + k * 1024); } while (0)
#define PG8_LDB(dst, b, h) do { _Pragma("unroll") for (int n = 0; n < 2; ++n) _Pragma("unroll") for (int k = 0; k < 2; ++k) dst[n][k] = *(const LAS bf16x8*)(lds + PG8_SB(b, h) + boff + n * 2048 + k * 1024); } while (0)
#define PG8_MMA(ai, bj, At, Bt) do { __builtin_amdgcn_s_setprio(1); _Pragma("unroll") for (int m = 0; m < 4; ++m) _Pragma("unroll") for (int n = 0; n < 2; ++n) _Pragma("unroll") for (int k = 0; k < 2; ++k) \
        acc[ai][bj][m][n] = __builtin_amdgcn_mfma_f32_16x16x32_bf16(Bt[n][k], At[m][k], acc[ai][bj][m][n], 0, 0, 0); __builtin_amdgcn_s_setprio(0); } while (0)
#define PG8_WAIT_V(n) asm volatile("s_waitcnt vmcnt(" #n ")" ::: "memory")
#define PG8_WAIT_L(n) asm volatile("s_waitcnt lgkmcnt(" #n ")" ::: "memory")
#define PG8_BAR __builtin_amdgcn_s_barrier()
#define PG8_SCHED __builtin_amdgcn_sched_barrier(0)
    Unit cur, nxt; int ui = 0;
    if (!S.next(0, cur)) return;
    f32x4 acc[2][2][4][2];
#pragma unroll
    for (int a = 0; a < 2; ++a)
#pragma unroll
        for (int b = 0; b < 2; ++b)
#pragma unroll
            for (int m = 0; m < 4; ++m)
#pragma unroll
                for (int n = 0; n < 2; ++n) acc[a][b][m][n] = (f32x4){0.f, 0.f, 0.f, 0.f};
    bf16x8 At[4][2], B0[2][2], B1[2][2];
    const char* cA = (const char*)g.A + (size_t)cur.pm * tstep; const char* cB = (const char*)g.Bt + (size_t)cur.pn * tstep;
    PG8_STAGE(PG8_SB(0, 0), cB, voffB); PG8_STAGE(PG8_SA(0, 0), cA, voffA); PG8_STAGE(PG8_SB(0, 1), cB + hstep, voffB); PG8_STAGE(PG8_SA(0, 1), cA + hstep, voffA);
    if (wr == 1) PG8_BAR;
    PG8_WAIT_V(4); PG8_BAR;
    PG8_STAGE(PG8_SB(1, 0), cB + kstep, voffB); PG8_STAGE(PG8_SA(1, 0), cA + kstep, voffA); PG8_STAGE(PG8_SB(1, 1), cB + hstep + kstep, voffB);
    PG8_WAIT_V(6); PG8_BAR;
    for (;;) {
        const bool has_next = S.next(ui + 1, nxt);
        const char* nA = has_next ? (const char*)g.A + (size_t)nxt.pm * tstep : cA; const char* nB = has_next ? (const char*)g.Bt + (size_t)nxt.pn * tstep : cB;
        for (int t = 0; t < nt; t += 2) {
            const bool last = (t == nt - 2);
            const char* a1 = cA + (size_t)(t + 1) * kstep;
            const char* a2 = last ? nA : cA + (size_t)(t + 2) * kstep; const char* b2 = last ? nB : cB + (size_t)(t + 2) * kstep;
            const char* a3 = a2 + kstep; const char* b3 = b2 + kstep;
            PG8_LDB(B0, 0, 0); PG8_SCHED; PG8_LDA(At, 0, 0); PG8_STAGE(PG8_SA(1, 1), a1 + hstep, voffA);
            PG8_WAIT_L(8); PG8_BAR; PG8_WAIT_L(0); PG8_MMA(0, 0, At, B0); PG8_BAR; PG8_SCHED;
            PG8_LDB(B1, 0, 1); PG8_STAGE(PG8_SB(0, 0), b2, voffB);
            PG8_BAR; PG8_WAIT_L(0); PG8_MMA(0, 1, At, B1); PG8_BAR;
            PG8_LDA(At, 0, 1); PG8_STAGE(PG8_SA(0, 0), a2, voffA);
            PG8_BAR; PG8_WAIT_L(0); PG8_MMA(1, 0, At, B0); PG8_BAR; PG8_SCHED;
            PG8_STAGE(PG8_SB(0, 1), b2 + hstep, voffB);
            PG8_WAIT_V(6); PG8_BAR; PG8_MMA(1, 1, At, B1); PG8_BAR;
            PG8_LDB(B0, 1, 0); PG8_SCHED; PG8_LDA(At, 1, 0); PG8_STAGE(PG8_SA(0, 1), a2 + hstep, voffA);
            PG8_WAIT_L(8); PG8_BAR; PG8_WAIT_L(0); PG8_MMA(0, 0, At, B0); PG8_BAR; PG8_SCHED;
            PG8_LDB(B1, 1, 1); PG8_STAGE(PG8_SB(1, 0), b3, voffB);
            PG8_BAR; PG8_WAIT_L(0); PG8_MMA(0, 1, At, B1); PG8_BAR;
            PG8_LDA(At, 1, 1); PG8_STAGE(PG8_SA(1, 0), a3, voffA);
            PG8_BAR; PG8_WAIT_L(0); PG8_MMA(1, 0, At, B0); PG8_BAR; PG8_SCHED;
            PG8_STAGE(PG8_SB(1, 1), b3 + hstep, voffB);
            PG8_WAIT_V(6); PG8_BAR; PG8_MMA(1, 1, At, B1); PG8_BAR;
        }
        E(acc, cur, wr, wc, fr, fq);
        if (!has_next) break;
#pragma unroll
        for (int a = 0; a < 2; ++a)
#pragma unroll
            for (int b = 0; b < 2; ++b)
#pragma unroll
                for (int m = 0; m < 4; ++m)
#pragma unroll
                    for (int n = 0; n < 2; ++n) acc[a][b][m][n] = (f32x4){0.f, 0.f, 0.f, 0.f};
        cur = nxt; cA = nA; cB = nB; ++ui;
    }
    PG8_WAIT_V(0);
    if (wr == 0) PG8_BAR;
    PG8_BAR;
#undef PG8_SA
#undef PG8_SB
#undef PG8_STAGE
#undef PG8_LDA
#undef PG8_LDB
#undef PG8_MMA
#undef PG8_WAIT_V
#undef PG8_WAIT_L
#undef PG8_BAR
#undef PG8_SCHED
}
}

enum { EM_PLAIN = 0, EM_Z, EM_LORA, EM_POOLW, EM_VUP, EM_MERGE };
struct Epi {
    static constexpr bool PERM = true;
    int mode, ldo, sub, accum;
    bf16_t* O;
    const float* b0; const float* b1;
    const bf16_t* X0;
    __device__ __forceinline__ void operator()(const f32x4 (&acc)[2][2][4][2], const pg8::Unit& u, int wr, int wc, int fr, int fq) const {
        const int pn = u.pn;
        int act = 0, ld = ldo, cb = pn * 256; bf16_t* base = O; const float* bias = nullptr;
        if (mode == EM_Z) {
            if (pn < 2) { ld = 512; cb = pn * 256; }
            else if (pn < 4) { base = O + (WS_ZQ - WS_ZP) / 2; ld = 512; cb = (pn - 2) * 256; }
            else if (pn < 16) { base = O + (WS_ZR - WS_ZP) / 2 + (size_t)((pn - 4) >> 2) * TH * 1024; ld = 1024; cb = ((pn - 4) & 3) * 256; }
            else if (pn == 16) { base = O + (WS_ZL - WS_ZP) / 2; ld = 256; cb = 0; }
            else { base = O + (WS_GATES - WS_ZP) / 2; ld = 3072; cb = (pn - 17) * 256; act = 1; bias = b0 + cb; }
        } else if (mode == EM_LORA) {
            const int seg = pn >> 2; base = O + (size_t)seg * TH * 1024; ld = 1024; cb = (pn & 3) * 256;
            act = seg == 0 ? 3 : (seg == 1 ? 2 : 0); bias = seg == 0 ? b0 + cb : b1 + cb;
        } else if (mode == EM_POOLW) { act = 4; }
        const int row0 = u.pm * 256 + wr * 64 + fr;
        const int cw = wc * 32 + 8 * fq;
#pragma unroll
        for (int ai = 0; ai < 2; ++ai)
#pragma unroll
            for (int m = 0; m < 4; ++m) {
                const size_t row = (size_t)(row0 + ai * 128 + m * 16);
#pragma unroll
                for (int bj = 0; bj < 2; ++bj) {
                    const int cl = bj * 128 + cw;
                    const int colg = pn * 256 + cl;
                    float v[8];
#pragma unroll
                    for (int e = 0; e < 4; ++e) { v[e] = acc[ai][bj][m][0][e]; v[4 + e] = acc[ai][bj][m][1][e]; }
                    if (mode == EM_MERGE) {
                        float gt[8]; unpack8(*(const u32x4*)(X0 + row * 3072 + sub * 1024 + colg), gt);
                        bf16_t* op = O + row * 1024 + colg;
                        if (!accum) {
#pragma unroll
                            for (int e = 0; e < 8; ++e) v[e] *= gt[e];
                        } else {
                            float old[8]; unpack8(*(const u32x4*)op, old);
#pragma unroll
                            for (int e = 0; e < 8; ++e) v[e] = old[e] + gt[e] * v[e];
                        }
                        *(u32x4*)op = pack8(v);
                    } else if (mode == EM_VUP) {
                        bf16_t* op = O + row * 1024 + colg;
                        float vl[8], vf[8]; unpack8(*(const u32x4*)op, vl); unpack8(*(const u32x4*)(X0 + row * 1024 + colg), vf);
                        const f32x4 c0 = *(const f32x4*)(b0 + colg), c1 = *(const f32x4*)(b0 + colg + 4);
#pragma unroll
                        for (int e = 0; e < 8; ++e) { const float bb = e < 4 ? c0[e & 3] : c1[e & 3]; v[e] = vl[e] + (vf[e] - vl[e]) * sigmoidf_(bb + v[e]); }
                        *(u32x4*)op = pack8(v);
                    } else {
                        bf16_t* op = base + row * ld + cb + cl;
                        if (act == 4) {
                            const f32x4 c0 = *(const f32x4*)(b0 + colg), c1 = *(const f32x4*)(b0 + colg + 4), s0 = *(const f32x4*)(b1 + colg), s1 = *(const f32x4*)(b1 + colg + 4);
#pragma unroll
                            for (int e = 0; e < 8; ++e) v[e] = (v[e] + (e < 4 ? c0[e & 3] : c1[e & 3])) * (e < 4 ? s0[e & 3] : s1[e & 3]);
                            *(u32x4*)op = pack8(v);
                        } else if (act == 0) {
                            *(u32x4*)op = pack8(v);
                        } else {
                            const f32x4 c0 = *(const f32x4*)(bias + cl), c1 = *(const f32x4*)(bias + cl + 4);
#pragma unroll
                            for (int e = 0; e < 8; ++e) v[e] = sigmoidf_(v[e] + (e < 4 ? c0[e & 3] : c1[e & 3]));
                            if (act == 1) *(u32x4*)op = pack8(v);
                            else {
                                if (act == 3) {
#pragma unroll
                                    for (int e = 0; e < 8; ++e) v[e] = 1.0f - __expf(-0.6065306597f * v[e]);
                                }
                                u32x4 w; w.x = pk_h2(v[0], v[1]); w.y = pk_h2(v[2], v[3]); w.z = pk_h2(v[4], v[5]); w.w = pk_h2(v[6], v[7]);
                                *(u32x4*)op = w;
                            }
                        }
                    }
                }
            }
    }
};

__device__ __forceinline__ void run_gemm(LAS unsigned char* lds, const bf16_t* A, const bf16_t* Bt, int M, int N, int K, const Epi& E) {
    pg8::Gemm g; g.A = A; g.Bt = Bt; g.M = M; g.N = N; g.K = K;
    pg8::StaticOrder S; S.init(M, N, (int)gridDim.x, (int)blockIdx.x);
    pg8::gemm_phase<Epi>(lds, g, S, E);
}
__device__ __forceinline__ void run_gemm_on(LAS unsigned char* lds, const bf16_t* A, const bf16_t* Bt, int M, int N, int K, const Epi& E, int first, int count) {
    const int b = (int)blockIdx.x - first;
    if (b < 0 || b >= count) return;
    pg8::Gemm g; g.A = A; g.Bt = Bt; g.M = M; g.N = N; g.K = K;
    pg8::StaticOrder S; S.init(M, N, count, b);
    pg8::gemm_phase<Epi>(lds, g, S, E);
}
__device__ __forceinline__ Epi mk_epi(int mode, bf16_t* O, int ldo, const float* b0 = nullptr, const float* b1 = nullptr, const bf16_t* X0 = nullptr, int sub = 0, int accum = 0) {
    Epi e; e.mode = mode; e.ldo = ldo; e.sub = sub; e.accum = accum; e.O = O; e.b0 = b0; e.b1 = b1; e.X0 = X0; return e;
}

__device__ __forceinline__ void cvt_job(LAS float* tile, int& rot, bf16_t* dst, int dstLd, int nrows, const float* src, int srcLd, int srcK, int srcN, int k0) {
    const int tid = opaque_tid(), G = gridDim.x;
    const int tk = dstLd / 256, tn = nrows / 64, ntiles = tk * tn;
    for (int t = (int)((blockIdx.x + G - (rot % G)) % G); t < ntiles; t += G) {
        const int tn0 = (t / tk) * 64, tk0 = (t % tk) * 256;
        {
            const int kk = tid >> 4, n4 = (tid & 15) * 4, n = tn0 + n4;
            f32x4 v[8];
#pragma unroll
            for (int p = 0; p < 8; ++p) {
                const int ks = tk0 + kk + p * 32 - k0;
                v[p] = (f32x4){0.f, 0.f, 0.f, 0.f};
                if (ks >= 0 && ks < srcK && n < srcN) v[p] = *(const f32x4*)(src + (size_t)ks * srcLd + n);
            }
#pragma unroll
            for (int p = 0; p < 8; ++p) { const int kl = kk + p * 32; tile[kl * 65 + n4 + 0] = v[p][0]; tile[kl * 65 + n4 + 1] = v[p][1]; tile[kl * 65 + n4 + 2] = v[p][2]; tile[kl * 65 + n4 + 3] = v[p][3]; }
        }
        __syncthreads();
        {
            const int n = tid >> 3;
#pragma unroll
            for (int p = 0; p < 4; ++p) {
                const int k8 = (tid & 7) * 8 + p * 64;
                float v[8];
#pragma unroll
                for (int e = 0; e < 8; ++e) v[e] = tile[(k8 + e) * 65 + n];
                *(u32x4*)(dst + (size_t)(tn0 + n) * dstLd + tk0 + k8) = pack8(v);
            }
        }
        __syncthreads();
    }
    rot += ntiles;
}

__device__ __forceinline__ void cvt_mixer(LAS unsigned char* lds, const Params& p, int l) {
    LAS float* tile = (LAS float*)lds; int rot = 0; size_t wo = WS_W; asm volatile("" : "+s"(wo)); unsigned char* W = p.ws + wo;
    cvt_job(tile, rot, (bf16_t*)(W + W_IN), 1024, INC, p.w_in + (size_t)l * 1024 * INC, INC, 1024, INC, 0);
    for (int g = 0; g < 4; ++g) cvt_job(tile, rot, (bf16_t*)(W + W_POOL) + (size_t)g * 128 * 512, 512, 128, p.pool_w + ((size_t)l * 4 + g) * 128 * 128, 128, 128, 128, g * 128);
    cvt_job(tile, rot, (bf16_t*)(W + W_PP), 512, 1024, p.w_proj_pool + (size_t)l * 512 * 1024, 1024, 512, 1024, 0);
    cvt_job(tile, rot, (bf16_t*)(W + W_K), 1024, 512, p.w_mem_kv + (size_t)l * 1024 * 1024, 1024, 1024, 512, 0);
    cvt_job(tile, rot, (bf16_t*)(W + W_V), 1024, 512, p.w_mem_kv + (size_t)l * 1024 * 1024 + 512, 1024, 1024, 512, 0);
    cvt_job(tile, rot, (bf16_t*)(W + W_PM), 512, 1024, p.w_proj_mem + (size_t)l * 512 * 1024, 1024, 512, 1024, 0);
    cvt_job(tile, rot, (bf16_t*)(W + W_LORA), 256, 1024, p.w_up_decay + (size_t)l * 64 * 1024, 1024, 64, 1024, 0);
    cvt_job(tile, rot, (bf16_t*)(W + W_LORA) + (size_t)1024 * 256, 256, 1024, p.w_up_a + (size_t)l * 64 * 1024, 1024, 64, 1024, 64);
    cvt_job(tile, rot, (bf16_t*)(W + W_LORA) + (size_t)2048 * 256, 256, 1024, p.w_up_g + (size_t)l * 128 * 1024, 1024, 128, 1024, 128);
    if (l > 0) {
        cvt_job(tile, rot, (bf16_t*)(W + W_DOWN), 1024, 256, p.w_down_v + (size_t)(l - 1) * 1024 * 32, 32, 1024, 32, 0);
        cvt_job(tile, rot, (bf16_t*)(W + W_UP), 256, 1024, p.w_up_v + (size_t)(l - 1) * 32 * 1024, 1024, 32, 1024, 0);
    }
    cvt_job(tile, rot, (bf16_t*)(W + W_PR), 1024, 1024, p.w_proj_rwkv + (size_t)l * 1024 * 1024, 1024, 1024, 1024, 0);
    cvt_job(tile, rot, (bf16_t*)(W + W_O), 1024, 1024, p.w_o + (size_t)l * 1024 * 1024, 1024, 1024, 1024, 0);
}
__device__ __forceinline__ void cvt_ffn(LAS unsigned char* lds, const Params& p, int l) {
    LAS float* tile = (LAS float*)lds; int rot = 0; size_t wo = WS_W; asm volatile("" : "+s"(wo)); unsigned char* W = p.ws + wo;
    cvt_job(tile, rot, (bf16_t*)(W + W_FU), 1024, 2 * DFF, p.w_ffn_up + (size_t)l * 1024 * 2 * DFF, 2 * DFF, 1024, 2 * DFF, 0);
    cvt_job(tile, rot, (bf16_t*)(W + W_FD), DFF, 1024, p.w_ffn_down + (size_t)l * DFF * 1024, 1024, DFF, 1024, 0);
}

__device__ __forceinline__ void row_phase(const float* xin, const bf16_t* y, const float* gpost, float* xout, const float* gpre, bf16_t* hout, int rows, const bf16_t* y2 = nullptr) {
    const int tid_ = opaque_tid(); const int wid = tid_ >> 6, lane = tid_ & 63;
    for (int r = blockIdx.x * 8 + wid; r < rows; r += gridDim.x * 8) {
        f32x4 x[4];
#pragma unroll
        for (int i = 0; i < 4; ++i) x[i] = *(const f32x4*)(xin + (size_t)r * D + i * 256 + lane * 4);
        if (y) {
            float yv[4][4]; float ss = 0.f;
#pragma unroll
            for (int i = 0; i < 4; ++i) { const u32x2 w = *(const u32x2*)(y + (size_t)r * D + i * 256 + lane * 4);
                yv[i][0] = bf_lo(w.x); yv[i][1] = bf_hi(w.x); yv[i][2] = bf_lo(w.y); yv[i][3] = bf_hi(w.y);
                if (y2) { const u32x2 w2 = *(const u32x2*)(y2 + (size_t)r * D + i * 256 + lane * 4); yv[i][0] += bf_lo(w2.x); yv[i][1] += bf_hi(w2.x); yv[i][2] += bf_lo(w2.y); yv[i][3] += bf_hi(w2.y); }
#pragma unroll
                for (int e = 0; e < 4; ++e) ss += yv[i][e] * yv[i][e]; }
            ss = wave_sum_dpp(ss);
            const float rs = rsqrtf(ss * (1.0f / D) + 1e-6f);
#pragma unroll
            for (int i = 0; i < 4; ++i) { const f32x4 g = *(const f32x4*)(gpost + i * 256 + lane * 4);
#pragma unroll
                for (int e = 0; e < 4; ++e) x[i][e] += yv[i][e] * rs * g[e];
                *(f32x4*)(xout + (size_t)r * D + i * 256 + lane * 4) = x[i]; }
        }
        if (hout) {
            float ss = 0.f;
#pragma unroll
            for (int i = 0; i < 4; ++i)
#pragma unroll
                for (int e = 0; e < 4; ++e) ss += x[i][e] * x[i][e];
            ss = wave_sum_dpp(ss);
            const float rs = rsqrtf(ss * (1.0f / D) + 1e-6f);
#pragma unroll
            for (int i = 0; i < 4; ++i) { const f32x4 g = *(const f32x4*)(gpre + i * 256 + lane * 4);
                u32x2 w; w.x = cvt_pk_bf16(x[i][0] * rs * g[0], x[i][1] * rs * g[1]); w.y = cvt_pk_bf16(x[i][2] * rs * g[2], x[i][3] * rs * g[3]);
                *(u32x2*)(hout + (size_t)r * D + i * 256 + lane * 4) = w; }
        }
    }
}

__device__ __forceinline__ void pool_phase(const bf16_t* zp, bf16_t* pooled) {
    const size_t total = (size_t)TH * 64, stride = (size_t)gridDim.x * 512;
    for (size_t i = (size_t)blockIdx.x * 512 + opaque_tid(); i < total; i += stride) {
        const int tok = (int)(i >> 6), c8 = (int)(i & 63), t = tok & (SEQ - 1);
        const int win = 2 << (c8 >> 4); const int n = (t + 1) < win ? (t + 1) : win;
        float s[8], self[8];
        unpack8(*(const u32x4*)(zp + (size_t)tok * 512 + c8 * 8), self);
#pragma unroll
        for (int e = 0; e < 8; ++e) s[e] = self[e];
        for (int j = 1; j < n; ++j) { float v[8]; unpack8(*(const u32x4*)(zp + (size_t)(tok - j) * 512 + c8 * 8), v);
#pragma unroll
            for (int e = 0; e < 8; ++e) s[e] += v[e]; }
        const float inv = 1.0f / (float)n;
#pragma unroll
        for (int e = 0; e < 8; ++e) s[e] = s[e] * inv - self[e];
        *(u32x4*)(pooled + (size_t)tok * 512 + c8 * 8) = pack8(s);
    }
}

__device__ __forceinline__ void prep_phase(const bf16_t* zrkv  , const bf16_t* zl, const float* mu, bf16_t* rl, bf16_t* kl, bf16_t* vl, bf16_t* Al, const float* k_k, float* kinv) {
    constexpr int STRIP = 32;
    const int items = 416 * (TH / STRIP), stride = (int)gridDim.x * 512;
    for (int it = (int)blockIdx.x * 512 + opaque_tid(); it < items; it += stride) {
        const int ci = it % 416, strip = it / 416, c = ci * 8, tok0 = strip * STRIP, t0 = tok0 & (SEQ - 1);
        const bf16_t* src; bf16_t* dst; int ld;
        if (c < 3072) { const int arr = c >> 10, cc = c & 1023; src = zrkv + (size_t)arr * TH * 1024 + cc; ld = 1024; dst = (arr == 0 ? rl : (arr == 1 ? kl : vl)) + cc; }
        else { src = zl + (c - 3072); ld = 256; dst = Al + (c - 3072); }
        const bool isk = c >= 1024 && c < 2048; const int cc = isk ? c - 1024 : 0, cl = c - 3072;
        float m[8], kq[8];
        { const f32x4 m0 = *(const f32x4*)(mu + c), m1 = *(const f32x4*)(mu + c + 4), q0 = *(const f32x4*)(k_k + cc), q1 = *(const f32x4*)(k_k + cc + 4);
#pragma unroll
          for (int e = 0; e < 4; ++e) { m[e] = m0[e]; m[4 + e] = m1[e]; kq[e] = q0[e]; kq[4 + e] = q1[e]; } }
        float zp[8];
        if (t0 > 0) unpack8(*(const u32x4*)(src + (size_t)(tok0 - 1) * ld), zp);
        else {
#pragma unroll
            for (int e = 0; e < 8; ++e) zp[e] = 0.f;
        }
#pragma unroll 4
        for (int i = 0; i < STRIP; ++i) {
            const size_t tok = (size_t)(tok0 + i);
            float z[8], o[8];
            unpack8(*(const u32x4*)(src + tok * ld), z);
            float ss = 0.f;
#pragma unroll
            for (int e = 0; e < 8; ++e) { o[e] = z[e] + (zp[e] - z[e]) * m[e]; zp[e] = z[e]; const float kk = o[e] * kq[e]; ss += kk * kk; }
            ss = sum8(ss);
            if (isk && (ci & 7) == 0) kinv[tok * 16 + (cc >> 6)] = rsqrtf(ss + 1e-12f);
            if (cl >= 0) {
                if (cl < 64) {
#pragma unroll
                    for (int e = 0; e < 8; ++e) o[e] = tanhf_(o[e]);
                } else if (cl >= 128) {
#pragma unroll
                    for (int e = 0; e < 8; ++e) o[e] = sigmoidf_(o[e]);
                }
            }
            *(u32x4*)(dst + tok * ld) = pack8(o);
        }
    }
}

__device__ __forceinline__ void attn_phase(LAS unsigned char* lds, bf16_t* zq, const bf16_t* Kmem, const bf16_t* Vt, int half) {
    LAS bf16_t* Ks = (LAS bf16_t*)lds;
    LAS bf16_t* Vs = (LAS bf16_t*)(lds + 256 * 136 * 2);
    const int tid = opaque_tid(), wid = tid >> 6, lane = tid & 63, fr = lane & 15, fq = lane >> 4;
    for (int it0 = blockIdx.x; it0 < 256; it0 += gridDim.x) {
        const int item = ((it0 & 7) << 5) | (it0 >> 3);
        const int bl = item >> 6, h = (item >> 4) & 3, qt = item & 15, gb = half * 4 + bl;
#pragma unroll
        for (int i = 0; i < 8; ++i) { const int ch = tid + i * 512, m = ch >> 4, d8 = (ch & 15) * 8;
            *(LAS u32x4*)(Ks + m * 136 + d8) = *(const u32x4*)(Kmem + (size_t)(gb * 256 + m) * 512 + h * 128 + d8); }
#pragma unroll
        for (int i = 0; i < 8; ++i) { const int ch = tid + i * 512, d = ch >> 5, m8 = (ch & 31) * 8;
            *(LAS u32x4*)(Vs + d * 264 + m8) = *(const u32x4*)(Vt + (size_t)(h * 128 + d) * 2048 + gb * 256 + m8); }
        __syncthreads();
        const size_t tok = (size_t)bl * SEQ + qt * 128 + wid * 16 + fr;
        bf16_t* qp = zq + tok * 512 + h * 128;
        bf16x8 q[4];
#pragma unroll
        for (int ks = 0; ks < 4; ++ks) q[ks] = *(const bf16x8*)(qp + ks * 32 + fq * 8);
        f32x4 sacc[16];
#pragma unroll
        for (int n = 0; n < 16; ++n) sacc[n] = (f32x4){0.f, 0.f, 0.f, 0.f};
#pragma unroll
        for (int n = 0; n < 16; ++n)
#pragma unroll
            for (int ks = 0; ks < 4; ++ks) { const bf16x8 kf = *(const LAS bf16x8*)(Ks + (16 * n + fr) * 136 + ks * 32 + fq * 8);
                sacc[n] = __builtin_amdgcn_mfma_f32_16x16x32_bf16(kf, q[ks], sacc[n], 0, 0, 0); }
        float mx = -3.0e38f;
#pragma unroll
        for (int n = 0; n < 16; ++n)
#pragma unroll
            for (int e = 0; e < 4; ++e) mx = fmaxf(mx, sacc[n][e]);
        mx = fmaxf(mx, __shfl_xor(mx, 16)); mx = fmaxf(mx, __shfl_xor(mx, 32));
        const float sc = 0.08838834764831845f;
        float sum = 0.f;
#pragma unroll
        for (int n = 0; n < 16; ++n)
#pragma unroll
            for (int e = 0; e < 4; ++e) { const float pz = __expf((sacc[n][e] - mx) * sc); sacc[n][e] = pz; sum += pz; }
        sum += __shfl_xor(sum, 16); sum += __shfl_xor(sum, 32);
        f32x4 oacc[8];
#pragma unroll
        for (int n = 0; n < 8; ++n) oacc[n] = (f32x4){0.f, 0.f, 0.f, 0.f};
#pragma unroll
        for (int kk = 0; kk < 8; ++kk) {
            u32x4 pw; pw.x = cvt_pk_bf16(sacc[2 * kk][0], sacc[2 * kk][1]); pw.y = cvt_pk_bf16(sacc[2 * kk][2], sacc[2 * kk][3]);
            pw.z = cvt_pk_bf16(sacc[2 * kk + 1][0], sacc[2 * kk + 1][1]); pw.w = cvt_pk_bf16(sacc[2 * kk + 1][2], sacc[2 * kk + 1][3]);
            const bf16x8 pf = __builtin_bit_cast(bf16x8, pw);
#pragma unroll
            for (int n = 0; n < 8; ++n) {
                const u32x2 v0 = *(const LAS u32x2*)(Vs + (16 * n + fr) * 264 + 32 * kk + 4 * fq), v1 = *(const LAS u32x2*)(Vs + (16 * n + fr) * 264 + 32 * kk + 16 + 4 * fq);
                u32x4 vw; vw.x = v0.x; vw.y = v0.y; vw.z = v1.x; vw.w = v1.y;
                oacc[n] = __builtin_amdgcn_mfma_f32_16x16x32_bf16(__builtin_bit_cast(bf16x8, vw), pf, oacc[n], 0, 0, 0);
            }
        }
        const float inv = 1.0f / sum;
#pragma unroll
        for (int n = 0; n < 8; ++n) { u32x2 w; w.x = cvt_pk_bf16(oacc[n][0] * inv, oacc[n][1] * inv); w.y = cvt_pk_bf16(oacc[n][2] * inv, oacc[n][3] * inv);
            *(u32x2*)(qp + 16 * n + 4 * fq) = w; }
        __syncthreads();
    }
}

struct ScanRaw { u32x2 r, k, v, om, a; float inv; };
typedef float f32x2 __attribute__((ext_vector_type(2)));
__device__ __forceinline__ void scan_bar() { asm volatile("s_waitcnt lgkmcnt(0)\n\ts_barrier" ::: "memory"); }
__device__ __forceinline__ void unpack4(const u32x2 w, float (&v)[4]) { v[0] = bf_lo(w.x); v[1] = bf_hi(w.x); v[2] = bf_lo(w.y); v[3] = bf_hi(w.y); }
__device__ __forceinline__ void unpack4h(const u32x2 w, float (&v)[4]) {
    typedef _Float16 h2 __attribute__((ext_vector_type(2)));
    const unsigned w0 = w.x, w1 = w.y; const h2 a = __builtin_bit_cast(h2, w0), b = __builtin_bit_cast(h2, w1);
    v[0] = (float)a.x; v[1] = (float)a.y; v[2] = (float)b.x; v[3] = (float)b.y;
}
__device__ __forceinline__ void scan_phase(LAS unsigned char* lds, const bf16_t* rl, const bf16_t* kl, const bf16_t* vl, const bf16_t* omw, const bf16_t* aa, const float* kinv, bf16_t* y, const float* k_k, const float* k_a) {
    constexpr int CH = 32, REC = 320, NC = SEQ / CH, YB = (CH / 4) * 16 * 17 * 4;
    LAS float* bufs = (LAS float*)lds;
    LAS float* yp = (LAS float*)(lds + 2 * CH * REC * 4);
    LAS float* vb = yp + 2 * YB;
    const int tid = opaque_tid();
    const bool loader = tid >= 256;
    for (int it0 = blockIdx.x; it0 < 256; it0 += gridDim.x) {
        const int item = ((it0 & 7) << 5) | (it0 >> 3);
        const int bh = item >> 2, rg = item & 3, bl = bh >> 4, head = bh & 15;
        const size_t tok0 = (size_t)bl * SEQ; const int ch0 = head * 64;
        const int lt = tid & 255, ls = lt >> 4, cg4 = lt & 15, lc = ch0 + cg4 * 4;
        const int ys = lt >> 4, yrow = lt & 15;
        float kkc[4], kac[4];
#pragma unroll
        for (int e = 0; e < 4; ++e) { kkc[e] = k_k[lc + e]; kac[e] = k_a[lc + e]; }
        auto load_raw = [&](int chunk, int sub) { ScanRaw raw; const size_t tk = tok0 + (size_t)chunk * CH + ls + 16 * sub, idx = tk * 1024 + lc;
            raw.r = *(const u32x2*)(rl + idx); raw.k = *(const u32x2*)(kl + idx); raw.v = *(const u32x2*)(vl + idx); raw.om = *(const u32x2*)(omw + idx); raw.a = *(const u32x2*)(aa + idx);
            raw.inv = kinv[tk * 16 + head]; return raw; };
        ScanRaw rw0, rw1, rw2, rx0, rx1, rx2;
        auto prep_store = [&](LAS float* b, LAS float* vbuf, const ScanRaw& raw, int sub) {
            const int ls = (lt >> 4) + 16 * sub;
            float r[4], k[4], v[4], om[4], a[4];
            unpack4(raw.r, r); unpack4(raw.k, k); unpack4(raw.v, v); unpack4h(raw.om, om); unpack4h(raw.a, a);
            f32x4 an, w, bn, ke, rr, vv;
#pragma unroll
            for (int e = 0; e < 4; ++e) { const float kk = k[e] * (kkc[e] * raw.inv); an[e] = -kk; w[e] = 1.0f - om[e]; bn[e] = kk * a[e]; ke[e] = k[e] * (1.0f + (a[e] - 1.0f) * kac[e]); rr[e] = r[e]; vv[e] = v[e]; }
            LAS float* rec = b + ls * REC + cg4 * 4;
            *(LAS f32x4*)(rec) = an; *(LAS f32x4*)(rec + 64) = w; *(LAS f32x4*)(rec + 128) = bn; *(LAS f32x4*)(rec + 192) = ke; *(LAS f32x4*)(rec + 256) = rr;
            if ((cg4 >> 2) == rg) { LAS float* vd = vbuf + ((cg4 & 3) * 4) * CH + ls; vd[0] = vv[0]; vd[CH] = vv[1]; vd[2 * CH] = vv[2]; vd[3 * CH] = vv[3]; }
        };
        auto write_y = [&](int chunk) {
            if (lt < 16 * (CH / 4)) {
                const int g4 = lt >> 4, yrow4 = lt & 15;
                const LAS float* pp = yp + (chunk & 1) * YB + (g4 * 16 + yrow4) * 17 * 4;
                f32x4 t4 = *(const LAS f32x4*)(pp);
#pragma unroll
                for (int i = 1; i < 16; ++i) t4 += *(const LAS f32x4*)(pp + 4 * i);
                bf16_t* yd = y + (tok0 + (size_t)chunk * CH + 4 * g4) * 1024 + ch0 + rg * 16 + yrow4;
#pragma unroll
                for (int j = 0; j < 4; ++j) yd[(size_t)j * 1024] = (bf16_t)(cvt_pk_bf16(t4[j], 0.f) & 0xffffu);
            } };
        const int l = tid & 63, rloc = ((tid >> 6) & 3) * 4 + (l >> 4), c4 = (l & 15) * 4;
        f32x2 S01 = (f32x2){0.f, 0.f}, S23 = (f32x2){0.f, 0.f};

        if (loader) { rw0 = load_raw(0, 0); rx0 = load_raw(0, 1); prep_store(bufs, vb, rw0, 0); prep_store(bufs, vb, rx0, 1);
            rw0 = load_raw(1, 0); rx0 = load_raw(1, 1); rw1 = load_raw(2, 0); rx1 = load_raw(2, 1); rw2 = load_raw(3, 0); rx2 = load_raw(3, 1); }
        scan_bar();
        for (int c = 0; c < NC; ++c) {
            if (loader) {
                if (c + 1 < NC) { prep_store(bufs + ((c + 1) & 1) * (CH * REC), vb + ((c + 1) & 1) * (16 * CH), rw0, 0); prep_store(bufs + ((c + 1) & 1) * (CH * REC), vb + ((c + 1) & 1) * (16 * CH), rx0, 1); }
                rw0 = rw1; rw1 = rw2; rx0 = rx1; rx1 = rx2;
                if (c + 4 < NC) { rw2 = load_raw(c + 4, 0); rx2 = load_raw(c + 4, 1); }
                if (c >= 1) write_y(c - 1);
            } else {
                if ((tid >> 6) & 1) __builtin_amdgcn_s_sleep(1);
                LAS float* b = bufs + (c & 1) * (CH * REC);
                LAS float* yo = yp + (c & 1) * YB + (rloc * 17 + (l & 15)) * 4;
                f32x4 an = *(LAS f32x4*)(b + c4), w = *(LAS f32x4*)(b + 64 + c4), bn = *(LAS f32x4*)(b + 128 + c4), kx = *(LAS f32x4*)(b + 192 + c4), rr = *(LAS f32x4*)(b + 256 + c4);
                f32x4 v4[CH / 4];
#pragma unroll
                for (int g = 0; g < CH / 4; ++g) v4[g] = *(LAS f32x4*)(vb + (c & 1) * (16 * CH) + rloc * CH + 4 * g);
                f32x4 yq;
#pragma unroll
                for (int s = 0; s < CH; ++s) {
                    const f32x4 an_ = an, w_ = w, bn_ = bn, k_ = kx, r_ = rr; const float v_ = v4[s >> 2][s & 3];
                    if (s + 1 < CH) { LAS float* nb = b + (s + 1) * REC;
                        an = *(LAS f32x4*)(nb + c4); w = *(LAS f32x4*)(nb + 64 + c4); bn = *(LAS f32x4*)(nb + 128 + c4); kx = *(LAS f32x4*)(nb + 192 + c4); rr = *(LAS f32x4*)(nb + 256 + c4); }
                    f32x2 p2 = S01 * (f32x2){an_[0], an_[1]}; p2 = S23 * (f32x2){an_[2], an_[3]} + p2;
                    float sa = p2[0] + p2[1];
                    const f32x2 vv2 = (f32x2){v_, v_};
                    const f32x2 t01 = S01 * (f32x2){w_[0], w_[1]} + (f32x2){k_[0], k_[1]} * vv2, t23 = S23 * (f32x2){w_[2], w_[3]} + (f32x2){k_[2], k_[3]} * vv2;
                    sa = row16_sum(sa);
                    const f32x2 sa2 = (f32x2){sa, sa};
                    S01 = (f32x2){bn_[0], bn_[1]} * sa2 + t01; S23 = (f32x2){bn_[2], bn_[3]} * sa2 + t23;
                    f32x2 q2 = S01 * (f32x2){r_[0], r_[1]}; q2 = S23 * (f32x2){r_[2], r_[3]} + q2;
                    yq[s & 3] = q2[0] + q2[1];
                    if ((s & 3) == 3) *(LAS f32x4*)(yo + (s >> 2) * (16 * 17 * 4)) = yq;
                }
            }
            scan_bar();
        }
        if (loader) write_y(NC - 1);
        scan_bar();
    }
}

__device__ __forceinline__ void post_phase(bf16_t* y, const bf16_t* rl, const bf16_t* kl, const bf16_t* vl, const bf16_t* aa, const bf16_t* gg, const float* k_a, const float* r_k, const float* lnw, const float* lnb) {
    constexpr int STRIP = 8;
    const int items = 128 * (TH / STRIP), stride = (int)gridDim.x * 512;
    for (int it = (int)blockIdx.x * 512 + opaque_tid(); it < items; it += stride) {
        const int c = (it & 127) * 8; const size_t tok0 = (size_t)(it >> 7) * STRIP;
        float ka[8], rk[8], lw[8], lb[8];
        { const f32x4 a0 = *(const f32x4*)(k_a + c), a1 = *(const f32x4*)(k_a + c + 4), b0 = *(const f32x4*)(r_k + c), b1 = *(const f32x4*)(r_k + c + 4),
                      c0 = *(const f32x4*)(lnw + c), c1 = *(const f32x4*)(lnw + c + 4), d0 = *(const f32x4*)(lnb + c), d1 = *(const f32x4*)(lnb + c + 4);
#pragma unroll
          for (int e = 0; e < 4; ++e) { ka[e] = a0[e]; ka[4 + e] = a1[e]; rk[e] = b0[e]; rk[4 + e] = b1[e]; lw[e] = c0[e]; lw[4 + e] = c1[e]; lb[e] = d0[e]; lb[4 + e] = d1[e]; } }
#pragma unroll 2
        for (int i = 0; i < STRIP; ++i) {
            const size_t idx = (tok0 + i) * 1024 + c;
            float yv[8], r[8], k[8], v[8], a[8], g[8];
            unpack8(*(const u32x4*)(y + idx), yv); unpack8(*(const u32x4*)(rl + idx), r); unpack8(*(const u32x4*)(kl + idx), k); unpack8(*(const u32x4*)(vl + idx), v);
            unpack8h(*(const u32x4*)(aa + idx), a); unpack8(*(const u32x4*)(gg + idx), g);
            float s = 0.f, dot = 0.f;
#pragma unroll
            for (int e = 0; e < 8; ++e) { s += yv[e]; dot += r[e] * k[e] * (1.0f + (a[e] - 1.0f) * ka[e]) * rk[e]; }
            s = sum8(s); dot = sum8(dot);
            const float mu = s * (1.0f / 64.0f);
            float q = 0.f;
#pragma unroll
            for (int e = 0; e < 8; ++e) { const float d = yv[e] - mu; q += d * d; }
            q = sum8(q);
            const float rs = rsqrtf(q * (1.0f / 64.0f) + 64e-5f);
#pragma unroll
            for (int e = 0; e < 8; ++e) yv[e] = (((yv[e] - mu) * rs) * lw[e] + lb[e] + dot * v[e]) * g[e];
            *(u32x4*)(y + idx) = pack8(yv);
        }
    }
}

__device__ __forceinline__ void conv_phase(const bf16_t* u, bf16_t* fin, const float* cw, const float* cb) {
    constexpr int STRIP = 32;
    const int items = 352 * (TH / STRIP), stride = (int)gridDim.x * 512;
    for (int it = (int)blockIdx.x * 512 + opaque_tid(); it < items; it += stride) {
        const int chunk = it % 352, strip = it / 352, n = chunk * 8, tok0 = strip * STRIP, t0 = tok0 & (SEQ - 1);
        float wg[3][8], wv[3][8], bg[8], bv[8];
#pragma unroll
        for (int j = 0; j < 3; ++j) {
            const f32x4 a0 = *(const f32x4*)(cw + j * 2 * DFF + n), a1 = *(const f32x4*)(cw + j * 2 * DFF + n + 4), b0 = *(const f32x4*)(cw + j * 2 * DFF + DFF + n), b1 = *(const f32x4*)(cw + j * 2 * DFF + DFF + n + 4);
#pragma unroll
            for (int e = 0; e < 4; ++e) { wg[j][e] = a0[e]; wg[j][4 + e] = a1[e]; wv[j][e] = b0[e]; wv[j][4 + e] = b1[e]; }
        }
        {
            const f32x4 a0 = *(const f32x4*)(cb + n), a1 = *(const f32x4*)(cb + n + 4), b0 = *(const f32x4*)(cb + DFF + n), b1 = *(const f32x4*)(cb + DFF + n + 4);
#pragma unroll
            for (int e = 0; e < 4; ++e) { bg[e] = a0[e]; bg[4 + e] = a1[e]; bv[e] = b0[e]; bv[4 + e] = b1[e]; }
        }
        float g2[8], v2[8], g1[8], v1[8];
        if (t0 >= 2) {
            unpack8(*(const u32x4*)(u + (size_t)(tok0 - 2) * (2 * DFF) + n), g2); unpack8(*(const u32x4*)(u + (size_t)(tok0 - 2) * (2 * DFF) + DFF + n), v2);
            unpack8(*(const u32x4*)(u + (size_t)(tok0 - 1) * (2 * DFF) + n), g1); unpack8(*(const u32x4*)(u + (size_t)(tok0 - 1) * (2 * DFF) + DFF + n), v1);
        } else {
#pragma unroll
            for (int e = 0; e < 8; ++e) { g2[e] = 0.f; v2[e] = 0.f; g1[e] = 0.f; v1[e] = 0.f; }
        }
#pragma unroll 4
        for (int i = 0; i < STRIP; ++i) {
            const size_t tok = (size_t)(tok0 + i);
            float g0[8], v0[8], o[8];
            unpack8(*(const u32x4*)(u + tok * (2 * DFF) + n), g0); unpack8(*(const u32x4*)(u + tok * (2 * DFF) + DFF + n), v0);
#pragma unroll
            for (int e = 0; e < 8; ++e) {
                const float x = bg[e] + wg[0][e] * g2[e] + wg[1][e] * g1[e] + wg[2][e] * g0[e];
                const float vv = bv[e] + wv[0][e] * v2[e] + wv[1][e] * v1[e] + wv[2][e] * v0[e];
                o[e] = x * sigmoidf_(1.5957691216f * (x + 0.044715f * x * x * x)) * vv;
                g2[e] = g1[e]; g1[e] = g0[e]; v2[e] = v1[e]; v1[e] = v0[e];
            }
            *(u32x4*)(fin + tok * DFF + n) = pack8(o);
        }
    }
}

#define XB_TMO      128
#define XB_XCNT(j)  (256  + 64 * (j))
#define XB_XSUB(j)  (1280 + 64 * (j))
#define XB_XGEN(j)  (2304 + 64 * (j))
#define XB_TOP      3328
#define XB_TOPGEN   3392
#define XCD_BAR_WORDS 3456
#define XB_SPIN_CAP (1u << 18)
__device__ __forceinline__ unsigned xb_ld(unsigned* p)              { return __hip_atomic_load(p, __ATOMIC_RELAXED, __HIP_MEMORY_SCOPE_AGENT); }
__device__ __forceinline__ unsigned xb_add(unsigned* p, unsigned v) { return __hip_atomic_fetch_add(p, v, __ATOMIC_RELAXED, __HIP_MEMORY_SCOPE_AGENT); }
__device__ __forceinline__ unsigned xb_xcc_id() { return (unsigned)__builtin_amdgcn_s_getreg((3 << 11) | 20) & 0xFu; }
#define XB_SPIN(cond, bar) do { unsigned _sp = 0; while (cond) { __builtin_amdgcn_s_sleep(1); \
    if ((++_sp & 255u) == 0u) { if (xb_ld(&(bar)[XB_TMO])) break; if (_sp > XB_SPIN_CAP) { atomicAdd(&(bar)[XB_TMO], 1u); break; } } } } while (0)
struct XcdBarrier { unsigned* bar; unsigned x; volatile LAS unsigned* st; };
__device__ __forceinline__ XcdBarrier xcd_barrier_post(unsigned* bar, volatile LAS unsigned* st) {
    XcdBarrier b; b.bar = bar; b.x = xb_xcc_id(); b.st = st;
    if (threadIdx.x == 0) (void)xb_add(&bar[XB_XCNT(b.x)], 1u);
    return b;
}
__device__ __forceinline__ void xcd_barrier_complete(unsigned* bar, unsigned x, unsigned& nloc, unsigned& nx) {
    const unsigned G = gridDim.x * gridDim.y * gridDim.z;
    unsigned sum, cnt, mine, sp = 0u;
    for (;;) {
        sum = 0u; cnt = 0u; mine = 0u;
#pragma unroll
        for (unsigned j = 0; j < 16; ++j) { const unsigned c = xb_ld(&bar[XB_XCNT(j)]); sum += c; cnt += (c > 0u) ? 1u : 0u; mine = (j == x) ? c : mine; }
        if (sum == G) break;
        __builtin_amdgcn_s_sleep(1);
        if ((++sp & 255u) == 0u) { if (xb_ld(&bar[XB_TMO])) break; if (sp > XB_SPIN_CAP) { atomicAdd(&bar[XB_TMO], 1u); break; } }
    }
    nloc = mine > 0u ? mine : 1u; nx = cnt > 0u ? cnt : 1u;
}
__device__ __forceinline__ void xcd_barrier(const XcdBarrier& b) {
    asm volatile("s_waitcnt vmcnt(0)" ::: "memory");
    __syncthreads();
    if (threadIdx.x == 0) {
        unsigned* bar = b.bar;
        __builtin_amdgcn_s_waitcnt(0);
        unsigned nloc = b.st[0], nx = b.st[1];
        if (nloc == 0u) { xcd_barrier_complete(bar, b.x, nloc, nx); b.st[0] = nloc; b.st[1] = nx; }
        const unsigned old = xb_add(&bar[XB_XSUB(b.x)], 1u);
        const unsigned gen = old / nloc;
        if (old + 1u == (gen + 1u) * nloc) {
            __builtin_amdgcn_fence(__ATOMIC_RELEASE, "agent");
            asm volatile("s_waitcnt vmcnt(0)" ::: "memory");
            const unsigned og = xb_add(&bar[XB_TOP], 1u);
            const unsigned tg = og / nx;
            if (og + 1u == (tg + 1u) * nx) xb_add(&bar[XB_TOPGEN], 1u);
            else XB_SPIN(xb_ld(&bar[XB_TOPGEN]) == tg, bar);
            __builtin_amdgcn_fence(__ATOMIC_ACQUIRE, "agent");
            xb_add(&bar[XB_XGEN(b.x)], 1u);
            asm volatile("s_waitcnt vmcnt(0)" ::: "memory");
        } else {
            XB_SPIN(xb_ld(&bar[XB_XGEN(b.x)]) == gen, bar);
            __builtin_amdgcn_fence(__ATOMIC_ACQUIRE, "agent");
            asm volatile("s_waitcnt vmcnt(0)" ::: "memory");
        }
    }
    __syncthreads();
}
constexpr size_t WS_BAR = 254 * MiB;

__global__ void __launch_bounds__(512, 2) fwd_megakernel(Params p) {
    extern __shared__ __attribute__((aligned(16))) unsigned char shm[];
    LAS unsigned char* lds = (LAS unsigned char*)shm;
    cg::grid_group grid = cg::this_grid();
    volatile LAS unsigned* xst = (volatile LAS unsigned*)(lds + DYN_LDS - 16);
    if (threadIdx.x == 0) { xst[0] = 0u; xst[1] = 0u; }
    if (blockIdx.x == 0) for (int i = threadIdx.x; i < XCD_BAR_WORDS; i += 512) ((unsigned*)(p.ws + WS_BAR))[i] = 0u;
    __syncthreads();
    XcdBarrier xbar; xbar.bar = (unsigned*)(p.ws + WS_BAR); xbar.x = xb_xcc_id(); xbar.st = xst;
    auto wsp = [&](size_t off) -> bf16_t* { size_t o = off; asm volatile("" : "+s"(o)); return (bf16_t*)(p.ws + o); };
#define HBUF wsp(WS_H)
#define POOLED wsp(WS_H)
#define AL wsp(WS_H + 8 * MiB)
#define VD wsp(WS_H + 12 * MiB)
#define ZP wsp(WS_ZP)
#define ZQ wsp(WS_ZQ)
#define ZR wsp(WS_ZR)
#define ZK wsp(WS_ZK)
#define ZV wsp(WS_ZV)
#define ZL wsp(WS_ZL)
#define GATES wsp(WS_GATES)
#define RL wsp(WS_RL)
#define KL wsp(WS_KL)
#define WT(off) ((const bf16_t*)wsp(WS_W + (off)))

    for (int l = 0; l < 2; ++l) {
        row_phase(p.mem, nullptr, nullptr, nullptr, p.mem_norm, wsp(WS_MEMN), 2048);
        cvt_mixer(lds, p, l);
        row_phase(l == 0 ? p.x : p.out, nullptr, nullptr, nullptr, p.norm_mix_pre + l * D, HBUF, TH);
        if (l == 0) { grid.sync(); if (threadIdx.x == 0) (void)xb_add(&xbar.bar[XB_XCNT(xbar.x)], 1u); }
        else xcd_barrier(xbar);
        for (int hb = 0; hb < 2; ++hb) {
            const size_t xoff = (size_t)hb * TH * D;
            const float* xin = (l == 0 ? p.x : p.out) + xoff;
            const size_t vf_off = WS_VFIRST + xoff * 2, vl_off = l == 0 ? vf_off : WS_VL;
            run_gemm(lds, HBUF, WT(W_IN), TH, INC, 1024, mk_epi(EM_Z, ZP, 0, p.gate_b + (size_t)l * 3 * D));
            if (hb == 0) {
                const int G = (int)gridDim.x, nz = (TH / 256) * (INC / 256), f0 = nz % G < G - 32 ? nz % G : 0;
                run_gemm_on(lds, wsp(WS_MEMN), WT(W_K), 2048, 512, 1024, mk_epi(EM_PLAIN, wsp(WS_KMEM), 512), f0, 16);
                run_gemm_on(lds, WT(W_V), wsp(WS_MEMN), 512, 2048, 1024, mk_epi(EM_PLAIN, wsp(WS_VT), 2048), f0 + 16, G - f0 - 16);
            }
            xcd_barrier(xbar);
            pool_phase(ZP, POOLED);
            prep_phase(ZR, ZL, p.mu_shift + (size_t)l * RWC, RL, KL, wsp(vl_off), AL, p.k_k + l * D, (float*)wsp(WS_KINV));
            attn_phase(lds, ZQ, wsp(WS_KMEM), wsp(WS_VT), hb);
            xcd_barrier(xbar);
            {
                const int G = (int)gridDim.x, nv = l > 0 ? G / 8 : 0, np = G / 4, nl = G - np - nv;
                run_gemm_on(lds, AL, WT(W_LORA), TH, 3072, 256, mk_epi(EM_LORA, ZR, 1024, p.w0 + l * D, p.a0 + l * D), 0, nl);
                run_gemm_on(lds, POOLED, WT(W_POOL), TH, 512, 512, mk_epi(EM_POOLW, ZP, 512, p.pool_b + l * 512, p.pool_scale + l * 512), nl, np);
                if (l > 0) run_gemm_on(lds, wsp(vl_off), WT(W_DOWN), TH, 256, 1024, mk_epi(EM_PLAIN, VD, 256), nl + np, nv);
            }
            xcd_barrier(xbar);
            if (l > 0) {
                run_gemm(lds, VD, WT(W_UP), TH, 1024, 256, mk_epi(EM_VUP, wsp(vl_off), 1024, p.v0 + (size_t)(l - 1) * D, nullptr, wsp(vf_off)));
                xcd_barrier(xbar);
            }
            scan_phase(lds, RL, KL, wsp(vl_off), ZR  , ZK  , (const float*)wsp(WS_KINV), HBUF, p.k_k + l * D, p.k_a + l * D);
            xcd_barrier(xbar);
            post_phase(HBUF, RL, KL, wsp(vl_off), ZK  , ZV  , p.k_a + l * D, p.r_k + l * D, p.ln_x_w + l * D, p.ln_x_b + l * D);
            xcd_barrier(xbar);
            {
                const int G = (int)gridDim.x, h0 = G / 2;
                run_gemm_on(lds, ZP, WT(W_PP), TH, 1024, 512, mk_epi(EM_MERGE, ZR  , 1024, nullptr, nullptr, GATES, 0, 0), 0, h0);
                run_gemm_on(lds, ZQ, WT(W_PM), TH, 1024, 512, mk_epi(EM_MERGE, ZR, 1024, nullptr, nullptr, GATES, 2, 1), 0, h0);
                run_gemm_on(lds, HBUF, WT(W_PR), TH, 1024, 1024, mk_epi(EM_MERGE, ZV  , 1024, nullptr, nullptr, GATES, 1, 0), h0, G - h0);
                xcd_barrier(xbar);
                run_gemm_on(lds, ZR, WT(W_O), TH, 1024, 1024, mk_epi(EM_PLAIN, ZK  , 1024), 0, h0);
                run_gemm_on(lds, ZV, WT(W_O), TH, 1024, 1024, mk_epi(EM_PLAIN, RL  , 1024), h0, G - h0);
                xcd_barrier(xbar);
            }
            row_phase(xin, ZK, p.norm_mix_post + l * D, p.out + xoff, nullptr, nullptr, TH, RL);
            if (hb == 0) row_phase((l == 0 ? p.x : p.out) + (size_t)TH * D, nullptr, nullptr, nullptr, p.norm_mix_pre + l * D, HBUF, TH);
            if (hb == 1) { cvt_ffn(lds, p, l); row_phase(p.out, nullptr, nullptr, nullptr, p.norm_ffn_pre + l * D, wsp(WS_H2), TH); }
            xcd_barrier(xbar);
        }
        for (int hb = 0; hb < 2; ++hb) {
            run_gemm(lds, wsp(WS_H2), WT(W_FU), TH, 2 * DFF, 1024, mk_epi(EM_PLAIN, wsp(WS_URAW), 2 * DFF));
            xcd_barrier(xbar);
            conv_phase(wsp(WS_URAW), wsp(WS_FIN) + (size_t)hb * TH * DFF, p.conv_w + (size_t)l * 3 * 2 * DFF, p.conv_b + (size_t)l * 2 * DFF);
            if (hb == 0) row_phase(p.out + (size_t)TH * D, nullptr, nullptr, nullptr, p.norm_ffn_pre + l * D, wsp(WS_H2), TH);
            xcd_barrier(xbar);
        }
        run_gemm(lds, wsp(WS_FIN), WT(W_FD), 2 * TH, 1024, DFF, mk_epi(EM_PLAIN, wsp(WS_F), 1024));
        xcd_barrier(xbar);
        row_phase(p.out, wsp(WS_F), p.norm_ffn_post + l * D, p.out, nullptr, nullptr, 2 * TH);
        if (l == 0) xcd_barrier(xbar);
    }
}

extern "C" void kernel_launch(void* const* d_in, const int* in_sizes, int n_in, void* d_out, int out_size, void* d_ws, size_t ws_size, hipStream_t stream) {
    static int grid_blocks = 0;
    if (!grid_blocks) {
        int dev = 0, cus = 0, per_cu = 0;
        hipGetDevice(&dev);
        hipDeviceGetAttribute(&cus, hipDeviceAttributeMultiprocessorCount, dev);
        hipFuncSetAttribute((const void*)fwd_megakernel, hipFuncAttributeMaxDynamicSharedMemorySize, DYN_LDS);
        hipOccupancyMaxActiveBlocksPerMultiprocessor(&per_cu, fwd_megakernel, 512, DYN_LDS);
        if (per_cu < 1) per_cu = 1;
        grid_blocks = cus * per_cu;
    }
    Params p{};
    const float** pp = (const float**)&p;
    for (int i = 0; i < 35; ++i) pp[i] = (const float*)d_in[i];
    p.out = (float*)d_out; p.ws = (unsigned char*)d_ws;
    void* args[] = {&p};
    hipError_t e = hipLaunchCooperativeKernel((void*)fwd_megakernel, dim3(grid_blocks), dim3(512), args, DYN_LDS, stream);
    if (e != hipSuccess) fprintf(stderr, "cooperative launch failed: %s (grid %d)\n", hipGetErrorString(e), grid_blocks);
}
```

```cpp
#include <hip/hip_runtime.h>
#include <hip/hip_cooperative_groups.h>
#include <cstdio>
namespace cg = cooperative_groups;

#define LAS __attribute__((address_space(3)))
typedef unsigned short bf16_t;
typedef short bf16x8 __attribute__((ext_vector_type(8)));
typedef float f32x4 __attribute__((ext_vector_type(4)));
typedef unsigned u32x4 __attribute__((ext_vector_type(4)));
typedef unsigned u32x2 __attribute__((ext_vector_type(2)));

constexpr int D = 1024, SEQ = 2048, TH = 8192  , DFF = 2816, INC = 7424, RWC = 3328;
constexpr size_t MiB = 1u << 20;
constexpr size_t WS_W = 0;
constexpr size_t W_IN = 0, W_POOL = 14 * MiB + MiB / 2, W_PP = 15 * MiB, W_K = 16 * MiB, W_V = 17 * MiB, W_PM = 18 * MiB, W_LORA = 19 * MiB,
                 W_DOWN = 20 * MiB + MiB / 2, W_UP = 21 * MiB, W_PR = 21 * MiB + MiB / 2, W_O = 23 * MiB + MiB / 2;
constexpr size_t W_FU = 0, W_FD = 11 * MiB;
constexpr size_t WS_MEMN = 26 * MiB, WS_KMEM = 30 * MiB, WS_VT = 32 * MiB, WS_VFIRST = 34 * MiB;
constexpr size_t WS_H = 66 * MiB;
constexpr size_t WS_ZP = 82 * MiB, WS_ZQ = 90 * MiB, WS_ZR = 98 * MiB, WS_ZK = 114 * MiB, WS_ZV = 130 * MiB, WS_ZL = 146 * MiB, WS_GATES = 150 * MiB;
constexpr size_t WS_RL = 198 * MiB, WS_KL = 214 * MiB, WS_VL = 230 * MiB;
constexpr size_t WS_H2 = 17 * MiB, WS_URAW = 66 * MiB, WS_FIN = 154 * MiB, WS_F = 66 * MiB;
constexpr size_t WS_KINV = 246 * MiB;
constexpr int DYN_LDS = 163840;

struct Params {
    const float *x, *mem, *mem_norm, *norm_mix_pre, *norm_mix_post, *w_in, *mu_shift, *pool_w, *pool_b, *pool_scale, *w_proj_pool, *w_mem_kv, *w_proj_mem, *w0, *w_up_decay,
        *a0, *w_up_a, *w_up_g, *k_k, *k_a, *r_k, *ln_x_w, *ln_x_b, *v0, *w_down_v, *w_up_v, *w_proj_rwkv, *gate_b, *w_o, *norm_ffn_pre, *norm_ffn_post, *w_ffn_up, *conv_w,
        *conv_b, *w_ffn_down;
    float* out;
    unsigned char* ws;
};

__device__ __forceinline__ unsigned cvt_pk_bf16(float lo, float hi) { unsigned r; asm("v_cvt_pk_bf16_f32 %0, %1, %2" : "=v"(r) : "v"(lo), "v"(hi)); return r; }
__device__ __forceinline__ float bf_lo(unsigned w) { return __uint_as_float(w << 16); }
__device__ __forceinline__ float bf_hi(unsigned w) { return __uint_as_float(w & 0xffff0000u); }
__device__ __forceinline__ void unpack8(const u32x4 w, float (&v)[8]) {
    v[0] = bf_lo(w.x); v[1] = bf_hi(w.x); v[2] = bf_lo(w.y); v[3] = bf_hi(w.y); v[4] = bf_lo(w.z); v[5] = bf_hi(w.z); v[6] = bf_lo(w.w); v[7] = bf_hi(w.w);
}
__device__ __forceinline__ u32x4 pack8(const float (&v)[8]) { u32x4 w; w.x = cvt_pk_bf16(v[0], v[1]); w.y = cvt_pk_bf16(v[2], v[3]); w.z = cvt_pk_bf16(v[4], v[5]); w.w = cvt_pk_bf16(v[6], v[7]); return w; }
__device__ __forceinline__ unsigned pk_h2(float a, float b) { typedef _Float16 h2 __attribute__((ext_vector_type(2))); h2 h; h.x = (_Float16)a; h.y = (_Float16)b; return __builtin_bit_cast(unsigned, h); }
__device__ __forceinline__ void unpack8h(const u32x4 w, float (&v)[8]) {
    typedef _Float16 h2 __attribute__((ext_vector_type(2)));
    const unsigned w0 = w.x, w1 = w.y, w2 = w.z, w3 = w.w;
    h2 a = __builtin_bit_cast(h2, w0), b = __builtin_bit_cast(h2, w1), c = __builtin_bit_cast(h2, w2), d = __builtin_bit_cast(h2, w3);
    v[0] = (float)a.x; v[1] = (float)a.y; v[2] = (float)b.x; v[3] = (float)b.y; v[4] = (float)c.x; v[5] = (float)c.y; v[6] = (float)d.x; v[7] = (float)d.y;
}
__device__ __forceinline__ float sigmoidf_(float x) { return __builtin_amdgcn_rcpf(1.0f + __expf(-x)); }
__device__ __forceinline__ float tanhf_(float x) { return 1.0f - 2.0f * __builtin_amdgcn_rcpf(1.0f + __expf(2.0f * x)); }
__device__ __forceinline__ float wave_sum(float v) {
#pragma unroll
    for (int o = 32; o >= 1; o >>= 1) v += __shfl_xor(v, o);
    return v;
}
__device__ __forceinline__ int opaque_tid() { int t = threadIdx.x; asm volatile("" : "+v"(t)); return t; }
template <int CTRL> __device__ __forceinline__ float dpp_f(float x) { return __int_as_float(__builtin_amdgcn_update_dpp(0, __float_as_int(x), CTRL, 0xF, 0xF, true)); }
__device__ __forceinline__ float row16_sum(float x) {
    x += dpp_f<0xB1>(x); x += dpp_f<0x4E>(x); x += dpp_f<0x141>(x); x += dpp_f<0x140>(x); return x;
}
__device__ __forceinline__ float sum8(float x) {
    x += dpp_f<0xB1>(x); x += dpp_f<0x4E>(x); x += dpp_f<0x141>(x); return x;
}
__device__ __forceinline__ float wave_sum_dpp(float x) {
    x = row16_sum(x);
    { const unsigned u = __float_as_uint(x); const auto r = __builtin_amdgcn_permlane16_swap(u, u, false, false); x = __uint_as_float(r[0]) + __uint_as_float(r[1]); }
    { const unsigned u = __float_as_uint(x); const auto r = __builtin_amdgcn_permlane32_swap(u, u, false, false); x = __uint_as_float(r[0]) + __uint_as_float(r[1]); }
    return x;
}

namespace pg8 {
constexpr int BM = 256, BK = 64, HALF = 128, HTB = HALF * BK * 2, STAGE_BYTES = 8 * HTB, NXCD = 8, WGM = 8;
__device__ __forceinline__ int lds_byte(int r, int c) { const int st = (r >> 4) * 2 + (c >> 5), rr = r & 15, cc = c & 31, ob = rr * 64 + cc * 2; return st * 1024 + (ob ^ (((ob >> 9) & 1) << 5)); }
__device__ __forceinline__ void stage_rc(int b, int& R, int& C) { const int st = b / 1024, sb = b % 1024, swz = sb ^ (((sb >> 9) & 1) << 5); R = (st >> 1) * 16 + swz / 64; C = (st & 1) * 32 + (swz % 64) / 2; }
__device__ __forceinline__ int perm32(int rho) { const int n = rho >> 4, i = rho & 15; return 8 * (i >> 2) + 4 * n + (i & 3); }
struct Unit { int pm, pn; };
struct Gemm { const bf16_t* A; const bf16_t* Bt; int M, N, K; };
struct StaticOrder {
    int nM, nN, nwg, G, c;
    __device__ void init(int M, int N, int G_, int c_) { nM = M / BM; nN = N / BM; nwg = nM * nN; G = G_; c = c_; }
    __device__ bool next(int i, Unit& u) const {
        const long L = (long)i * G + c; if (L >= nwg) return false;
        int wgid = (int)L; { const int q = nwg / NXCD, r = nwg % NXCD, xcd = wgid % NXCD, off = wgid / NXCD; wgid = (xcd < r ? xcd * (q + 1) : r * (q + 1) + (xcd - r) * q) + off; }
        const int nig = WGM * nN, gid = wgid / nig, fm = gid * WGM, gsz = (nM - fm) < WGM ? (nM - fm) : WGM;
        u.pm = fm + ((wgid % nig) % gsz); u.pn = (wgid % nig) / gsz; return true;
    }
};

template <class Epi>
__device__ __forceinline__ void gemm_phase(LAS unsigned char* lds, const Gemm g, const StaticOrder& S, const Epi& E) {
    const int tid = opaque_tid(), wid = __builtin_amdgcn_readfirstlane(tid >> 6), lane = tid & 63, wr = wid >> 2, wc = wid & 3, fr = lane & 15, fq = lane >> 4;
    const int K = g.K, nt = K / BK;
    unsigned voffA[2], voffB[2];
#pragma unroll
    for (int i = 0; i < 2; ++i) { int R, C; stage_rc(tid * 16 + i * 8192, R, C); const int Rb = Epi::PERM ? ((R & ~31) + perm32(R & 31)) : R;
        voffA[i] = (unsigned)(R * K + C) * 2u; voffB[i] = (unsigned)(Rb * K + C) * 2u; }
    const size_t kstep = (size_t)(BK * 2);
    const size_t hstep = (size_t)HALF * K * 2;
    const size_t tstep = 2 * hstep;
    const unsigned ldsw = (unsigned)wid * 1024u;
    const int aoff = lds_byte(wr * 64 + fr, fq * 8), boff = lds_byte(wc * 32 + fr, fq * 8);
#define PG8_SA(b, h) (((b) * 2 + (h)) * HTB)
#define PG8_SB(b, h) ((4 + (b) * 2 + (h)) * HTB)
#define PG8_STAGE(bufoff, gbase, voff) do { _Pragma("unroll") for (int _i = 0; _i < 2; ++_i) \
        __builtin_amdgcn_global_load_lds((const unsigned*)((const char*)(gbase) + (voff)[_i]), (LAS unsigned*)(lds + (bufoff) + ldsw + _i * 8192), 16, 0, 0); } while (0)
#define PG8_LDA(dst, b, h) do { _Pragma("unroll") for (int m = 0; m < 4; ++m) _Pragma("unroll") for (int k = 0; k < 2; ++k) dst[m][k] = *(const LAS bf16x8*)(lds + PG8_SA(b, h) + aoff + m * 2048 + k * 1024); } while (0)
#define PG8_LDB(dst, b, h) do { _Pragma("unroll") for (int n = 0; n < 2; ++n) _Pragma("unroll") for (int k = 0; k < 2; ++k) dst[n][k] = *(const LAS bf16x8*)(lds + PG8_SB(b, h) + boff + n * 2048 + k * 1024); } while (0)
#define PG8_MMA(ai, bj, At, Bt) do { __builtin_amdgcn_s_setprio(1); _Pragma("unroll") for (int m = 0; m < 4; ++m) _Pragma("unroll") for (int n = 0; n < 2; ++n) _Pragma("unroll") for (int k = 0; k < 2; ++k) \
        acc[ai][bj][m][n] = __builtin_amdgcn_mfma_f32_16x16x32_bf16(Bt[n][k], At[m][k], acc[ai][bj][m][n], 0, 0, 0); __builtin_amdgcn_s_setprio(0); } while (0)
#define PG8_WAIT_V(n) asm volatile("s_waitcnt vmcnt(" #n ")" ::: "memory")
#define PG8_WAIT_L(n) asm volatile("s_waitcnt lgkmcnt(" #n ")" ::: "memory")
#define PG8_BAR __builtin_amdgcn_s_barrier()
#define PG8_SCHED __builtin_amdgcn_sched_barrier(0)
    Unit cur, nxt; int ui = 0;
    if (!S.next(0, cur)) return;
    f32x4 acc[2][2][4][2];
#pragma unroll
    for (int a = 0; a < 2; ++a)
#pragma unroll
        for (int b = 0; b < 2; ++b)
#pragma unroll
            for (int m = 0; m < 4; ++m)
#pragma unroll
                for (int n = 0; n < 2; ++n) acc[a][b][m][n] = (f32x4){0.f, 0.f, 0.f, 0.f};
    bf16x8 At[4][2], B0[2][2], B1[2][2];
    const char* cA = (const char*)g.A + (size_t)cur.pm * tstep; const char* cB = (const char*)g.Bt + (size_t)cur.pn * tstep;
    PG8_STAGE(PG8_SB(0, 0), cB, voffB); PG8_STAGE(PG8_SA(0, 0), cA, voffA); PG8_STAGE(PG8_SB(0, 1), cB + hstep, voffB); PG8_STAGE(PG8_SA(0, 1), cA + hstep, voffA);
    if (wr == 1) PG8_BAR;
    PG8_WAIT_V(4); PG8_BAR;
    PG8_STAGE(PG8_SB(1, 0), cB + kstep, voffB); PG8_STAGE(PG8_SA(1, 0), cA + kstep, voffA); PG8_STAGE(PG8_SB(1, 1), cB + hstep + kstep, voffB);
    PG8_WAIT_V(6); PG8_BAR;
    for (;;) {
        const bool has_next = S.next(ui + 1, nxt);
        const char* nA = has_next ? (const char*)g.A + (size_t)nxt.pm * tstep : cA; const char* nB = has_next ? (const char*)g.Bt + (size_t)nxt.pn * tstep : cB;
        for (int t = 0; t < nt; t += 2) {
            const bool last = (t == nt - 2);
            const char* a1 = cA + (size_t)(t + 1) * kstep;
            const char* a2 = last ? nA : cA + (size_t)(t + 2) * kstep; const char* b2 = last ? nB : cB + (size_t)(t + 2) * kstep;
            const char* a3 = a2 + kstep; const char* b3 = b2 + kstep;
            PG8_LDB(B0, 0, 0); PG8_SCHED; PG8_LDA(At, 0, 0); PG8_STAGE(PG8_SA(1, 1), a1 + hstep, voffA);
            PG8_WAIT_L(8); PG8_BAR; PG8_WAIT_L(0); PG8_MMA(0, 0, At, B0); PG8_BAR; PG8_SCHED;
            PG8_LDB(B1, 0, 1); PG8_STAGE(PG8_SB(0, 0), b2, voffB);
            PG8_BAR; PG8_WAIT_L(0); PG8_MMA(0, 1, At, B1); PG8_BAR;
            PG8_LDA(At, 0, 1); PG8_STAGE(PG8_SA(0, 0), a2, voffA);
            PG8_BAR; PG8_WAIT_L(0); PG8_MMA(1, 0, At, B0); PG8_BAR; PG8_SCHED;
            PG8_STAGE(PG8_SB(0, 1), b2 + hstep, voffB);
            PG8_WAIT_V(6); PG8_BAR; PG8_MMA(1, 1, At, B1); PG8_BAR;
            PG8_LDB(B0, 1, 0); PG8_SCHED; PG8_LDA(At, 1, 0); PG8_STAGE(PG8_SA(0, 1), a2 + hstep, voffA);
            PG8_WAIT_L(8); PG8_BAR; PG8_WAIT_L(0); PG8_MMA(0, 0, At, B0); PG8_BAR; PG8_SCHED;
            PG8_LDB(B1, 1, 1); PG8_STAGE(PG8_SB(1, 0), b3, voffB);
            PG8_BAR; PG8_WAIT_L(0); PG8_MMA(0, 1, At, B1); PG8_BAR;
            PG8_LDA(At, 1, 1); PG8_STAGE(PG8_SA(1, 0), a3, voffA);
            PG8_BAR; PG8_WAIT_L(0); PG8_MMA(1, 0, At, B0); PG8_BAR; PG8_SCHED;
            PG8_STAGE(PG8_SB(1, 1), b3 + hstep, voffB);
            PG8_WAIT_V(6); PG8_BAR; PG8_MMA(1, 1, At, B1); PG8_BAR;
        }
        E(acc, cur, wr, wc, fr, fq);
        if (!has_next) break;
#pragma unroll
        for (int a = 0; a < 2; ++a)
#pragma unroll
            for (int b = 0; b < 2; ++b)
#pragma unroll
                for (int m = 0; m < 4; ++m)
#pragma unroll
                    for (int n = 0; n < 2; ++n) acc[a][b][m][n] = (f32x4){0.f, 0.f, 0.f, 0.f};
        cur = nxt; cA = nA; cB = nB; ++ui;
    }
    PG8_WAIT_V(0);
    if (wr == 0) PG8_BAR;
    PG8_BAR;
#undef PG8_SA
#undef PG8_SB
#undef PG8_STAGE
#undef PG8_LDA
#undef PG8_LDB
#undef PG8_MMA
#undef PG8_WAIT_V
#undef PG8_WAIT_L
#undef PG8_BAR
#undef PG8_SCHED
}
}

enum { EM_PLAIN = 0, EM_Z, EM_LORA, EM_POOLW, EM_VUP, EM_MERGE };
struct Epi {
    static constexpr bool PERM = true;
    int mode, ldo, sub, accum;
    bf16_t* O;
    const float* b0; const float* b1;
    const bf16_t* X0;
    __device__ __forceinline__ void operator()(const f32x4 (&acc)[2][2][4][2], const pg8::Unit& u, int wr, int wc, int fr, int fq) const {
        const int pn = u.pn;
        int act = 0, ld = ldo, cb = pn * 256; bf16_t* base = O; const float* bias = nullptr;
        if (mode == EM_Z) {
            if (pn < 2) { ld = 512; cb = pn * 256; }
            else if (pn < 4) { base = O + (WS_ZQ - WS_ZP) / 2; ld = 512; cb = (pn - 2) * 256; }
            else if (pn < 16) { base = O + (WS_ZR - WS_ZP) / 2 + (size_t)((pn - 4) >> 2) * TH * 1024; ld = 1024; cb = ((pn - 4) & 3) * 256; }
            else if (pn == 16) { base = O + (WS_ZL - WS_ZP) / 2; ld = 256; cb = 0; }
            else { base = O + (WS_GATES - WS_ZP) / 2; ld = 3072; cb = (pn - 17) * 256; act = 1; bias = b0 + cb; }
        } else if (mode == EM_LORA) {
            const int seg = pn >> 2; base = O + (size_t)seg * TH * 1024; ld = 1024; cb = (pn & 3) * 256;
            act = seg == 0 ? 3 : (seg == 1 ? 2 : 0); bias = seg == 0 ? b0 + cb : b1 + cb;
        } else if (mode == EM_POOLW) { act = 4; }
        const int row0 = u.pm * 256 + wr * 64 + fr;
        const int cw = wc * 32 + 8 * fq;
#pragma unroll
        for (int ai = 0; ai < 2; ++ai)
#pragma unroll
            for (int m = 0; m < 4; ++m) {
                const size_t row = (size_t)(row0 + ai * 128 + m * 16);
#pragma unroll
                for (int bj = 0; bj < 2; ++bj) {
                    const int cl = bj * 128 + cw;
                    const int colg = pn * 256 + cl;
                    float v[8];
#pragma unroll
                    for (int e = 0; e < 4; ++e) { v[e] = acc[ai][bj][m][0][e]; v[4 + e] = acc[ai][bj][m][1][e]; }
                    if (mode == EM_MERGE) {
                        float gt[8]; unpack8(*(const u32x4*)(X0 + row * 3072 + sub * 1024 + colg), gt);
                        bf16_t* op = O + row * 1024 + colg;
                        if (!accum) {
#pragma unroll
                            for (int e = 0; e < 8; ++e) v[e] *= gt[e];
                        } else {
                            float old[8]; unpack8(*(const u32x4*)op, old);
#pragma unroll
                            for (int e = 0; e < 8; ++e) v[e] = old[e] + gt[e] * v[e];
                        }
                        *(u32x4*)op = pack8(v);
                    } else if (mode == EM_VUP) {
                        bf16_t* op = O + row * 1024 + colg;
                        float vl[8], vf[8]; unpack8(*(const u32x4*)op, vl); unpack8(*(const u32x4*)(X0 + row * 1024 + colg), vf);
                        const f32x4 c0 = *(const f32x4*)(b0 + colg), c1 = *(const f32x4*)(b0 + colg + 4);
#pragma unroll
                        for (int e = 0; e < 8; ++e) { const float bb = e < 4 ? c0[e & 3] : c1[e & 3]; v[e] = vl[e] + (vf[e] - vl[e]) * sigmoidf_(bb + v[e]); }
                        *(u32x4*)op = pack8(v);
                    } else {
                        bf16_t* op = base + row * ld + cb + cl;
                        if (act == 4) {
                            const f32x4 c0 = *(const f32x4*)(b0 + colg), c1 = *(const f32x4*)(b0 + colg + 4), s0 = *(const f32x4*)(b1 + colg), s1 = *(const f32x4*)(b1 + colg + 4);
#pragma unroll
                            for (int e = 0; e < 8; ++e) v[e] = (v[e] + (e < 4 ? c0[e & 3] : c1[e & 3])) * (e < 4 ? s0[e & 3] : s1[e & 3]);
                            *(u32x4*)op = pack8(v);
                        } else if (act == 0) {
                            *(u32x4*)op = pack8(v);
                        } else {
                            const f32x4 c0 = *(const f32x4*)(bias + cl), c1 = *(const f32x4*)(bias + cl + 4);
#pragma unroll
                            for (int e = 0; e < 8; ++e) v[e] = sigmoidf_(v[e] + (e < 4 ? c0[e & 3] : c1[e & 3]));
                            if (act == 1) *(u32x4*)op = pack8(v);
                            else {
                                if (act == 3) {
#pragma unroll
                                    for (int e = 0; e < 8; ++e) v[e] = 1.0f - __expf(-0.6065306597f * v[e]);
                                }
                                u32x4 w; w.x = pk_h2(v[0], v[1]); w.y = pk_h2(v[2], v[3]); w.z = pk_h2(v[4], v[5]); w.w = pk_h2(v[6], v[7]);
                                *(u32x4*)op = w;
                            }
                        }
                    }
                }
            }
    }
};

__device__ __forceinline__ void run_gemm(LAS unsigned char* lds, const bf16_t* A, const bf16_t* Bt, int M, int N, int K, const Epi& E) {
    pg8::Gemm g; g.A = A; g.Bt = Bt; g.M = M; g.N = N; g.K = K;
    pg8::StaticOrder S; S.init(M, N, (int)gridDim.x, (int)blockIdx.x);
    pg8::gemm_phase<Epi>(lds, g, S, E);
}
__device__ __forceinline__ void run_gemm_on(LAS unsigned char* lds, const bf16_t* A, const bf16_t* Bt, int M, int N, int K, const Epi& E, int first, int count) {
    const int b = (int)blockIdx.x - first;
    if (b < 0 || b >= count) return;
    pg8::Gemm g; g.A = A; g.Bt = Bt; g.M = M; g.N = N; g.K = K;
    pg8::StaticOrder S; S.init(M, N, count, b);
    pg8::gemm_phase<Epi>(lds, g, S, E);
}
__device__ __forceinline__ Epi mk_epi(int mode, bf16_t* O, int ldo, const float* b0 = nullptr, const float* b1 = nullptr, const bf16_t* X0 = nullptr, int sub = 0, int accum = 0) {
    Epi e; e.mode = mode; e.ldo = ldo; e.sub = sub; e.accum = accum; e.O = O; e.b0 = b0; e.b1 = b1; e.X0 = X0; return e;
}

__device__ __forceinline__ void cvt_job(LAS float* tile, int& rot, bf16_t* dst, int dstLd, int nrows, const float* src, int srcLd, int srcK, int srcN, int k0) {
    const int tid = opaque_tid(), G = gridDim.x;
    const int tk = dstLd / 256, tn = nrows / 64, ntiles = tk * tn;
    for (int t = (int)((blockIdx.x + G - (rot % G)) % G); t < ntiles; t += G) {
        const int tn0 = (t / tk) * 64, tk0 = (t % tk) * 256;
        {
            const int kk = tid >> 4, n4 = (tid & 15) * 4, n = tn0 + n4;
            f32x4 v[8];
#pragma unroll
            for (int p = 0; p < 8; ++p) {
                const int ks = tk0 + kk + p * 32 - k0;
                v[p] = (f32x4){0.f, 0.f, 0.f, 0.f};
                if (ks >= 0 && ks < srcK && n < srcN) v[p] = *(const f32x4*)(src + (size_t)ks * srcLd + n);
            }
#pragma unroll
            for (int p = 0; p < 8; ++p) { const int kl = kk + p * 32; tile[kl * 65 + n4 + 0] = v[p][0]; tile[kl * 65 + n4 + 1] = v[p][1]; tile[kl * 65 + n4 + 2] = v[p][2]; tile[kl * 65 + n4 + 3] = v[p][3]; }
        }
        __syncthreads();
        {
            const int n = tid >> 3;
#pragma unroll
            for (int p = 0; p < 4; ++p) {
                const int k8 = (tid & 7) * 8 + p * 64;
                float v[8];
#pragma unroll
                for (int e = 0; e < 8; ++e) v[e] = tile[(k8 + e) * 65 + n];
                *(u32x4*)(dst + (size_t)(tn0 + n) * dstLd + tk0 + k8) = pack8(v);
            }
        }
        __syncthreads();
    }
    rot += ntiles;
}

__device__ __forceinline__ void cvt_mixer(LAS unsigned char* lds, const Params& p, int l) {
    LAS float* tile = (LAS float*)lds; int rot = 0; size_t wo = WS_W; asm volatile("" : "+s"(wo)); unsigned char* W = p.ws + wo;
    cvt_job(tile, rot, (bf16_t*)(W + W_IN), 1024, INC, p.w_in + (size_t)l * 1024 * INC, INC, 1024, INC, 0);
    for (int g = 0; g < 4; ++g) cvt_job(tile, rot, (bf16_t*)(W + W_POOL) + (size_t)g * 128 * 512, 512, 128, p.pool_w + ((size_t)l * 4 + g) * 128 * 128, 128, 128, 128, g * 128);
    cvt_job(tile, rot, (bf16_t*)(W + W_PP), 512, 1024, p.w_proj_pool + (size_t)l * 512 * 1024, 1024, 512, 1024, 0);
    cvt_job(tile, rot, (bf16_t*)(W + W_K), 1024, 512, p.w_mem_kv + (size_t)l * 1024 * 1024, 1024, 1024, 512, 0);
    cvt_job(tile, rot, (bf16_t*)(W + W_V), 1024, 512, p.w_mem_kv + (size_t)l * 1024 * 1024 + 512, 1024, 1024, 512, 0);
    cvt_job(tile, rot, (bf16_t*)(W + W_PM), 512, 1024, p.w_proj_mem + (size_t)l * 512 * 1024, 1024, 512, 1024, 0);
    cvt_job(tile, rot, (bf16_t*)(W + W_LORA), 256, 1024, p.w_up_decay + (size_t)l * 64 * 1024, 1024, 64, 1024, 0);
    cvt_job(tile, rot, (bf16_t*)(W + W_LORA) + (size_t)1024 * 256, 256, 1024, p.w_up_a + (size_t)l * 64 * 1024, 1024, 64, 1024, 64);
    cvt_job(tile, rot, (bf16_t*)(W + W_LORA) + (size_t)2048 * 256, 256, 1024, p.w_up_g + (size_t)l * 128 * 1024, 1024, 128, 1024, 128);
    if (l > 0) {
        cvt_job(tile, rot, (bf16_t*)(W + W_DOWN), 1024, 256, p.w_down_v + (size_t)(l - 1) * 1024 * 32, 32, 1024, 32, 0);
        cvt_job(tile, rot, (bf16_t*)(W + W_UP), 256, 1024, p.w_up_v + (size_t)(l - 1) * 32 * 1024, 1024, 32, 1024, 0);
    }
    cvt_job(tile, rot, (bf16_t*)(W + W_PR), 1024, 1024, p.w_proj_rwkv + (size_t)l * 1024 * 1024, 1024, 1024, 1024, 0);
    cvt_job(tile, rot, (bf16_t*)(W + W_O), 1024, 1024, p.w_o + (size_t)l * 1024 * 1024, 1024, 1024, 1024, 0);
}
__device__ __forceinline__ void cvt_ffn(LAS unsigned char* lds, const Params& p, int l) {
    LAS float* tile = (LAS float*)lds; int rot = 0; size_t wo = WS_W; asm volatile("" : "+s"(wo)); unsigned char* W = p.ws + wo;
    cvt_job(tile, rot, (bf16_t*)(W + W_FU), 1024, 2 * DFF, p.w_ffn_up + (size_t)l * 1024 * 2 * DFF, 2 * DFF, 1024, 2 * DFF, 0);
    cvt_job(tile, rot, (bf16_t*)(W + W_FD), DFF, 1024, p.w_ffn_down + (size_t)l * DFF * 1024, 1024, DFF, 1024, 0);
}

__device__ __forceinline__ void row_phase(const float* xin, const bf16_t* y, const float* gpost, float* xout, const float* gpre, bf16_t* hout, int rows, const bf16_t* y2 = nullptr) {
    const int tid_ = opaque_tid(); const int wid = tid_ >> 6, lane = tid_ & 63;
    f32x4 gq[4], gp[4];
#pragma unroll
    for (int i = 0; i < 4; ++i) { gq[i] = gpost ? *(const f32x4*)(gpost + i * 256 + lane * 4) : (f32x4){0.f, 0.f, 0.f, 0.f}; gp[i] = gpre ? *(const f32x4*)(gpre + i * 256 + lane * 4) : (f32x4){0.f, 0.f, 0.f, 0.f}; }
    for (int r = blockIdx.x * 8 + wid; r < rows; r += gridDim.x * 8) {
        f32x4 x[4];
#pragma unroll
        for (int i = 0; i < 4; ++i) x[i] = *(const f32x4*)(xin + (size_t)r * D + i * 256 + lane * 4);
        if (y) {
            float yv[4][4]; float ss = 0.f;
#pragma unroll
            for (int i = 0; i < 4; ++i) { const u32x2 w = *(const u32x2*)(y + (size_t)r * D + i * 256 + lane * 4);
                yv[i][0] = bf_lo(w.x); yv[i][1] = bf_hi(w.x); yv[i][2] = bf_lo(w.y); yv[i][3] = bf_hi(w.y);
                if (y2) { const u32x2 w2 = *(const u32x2*)(y2 + (size_t)r * D + i * 256 + lane * 4); yv[i][0] += bf_lo(w2.x); yv[i][1] += bf_hi(w2.x); yv[i][2] += bf_lo(w2.y); yv[i][3] += bf_hi(w2.y); }
#pragma unroll
                for (int e = 0; e < 4; ++e) ss += yv[i][e] * yv[i][e]; }
            ss = wave_sum_dpp(ss);
            const float rs = rsqrtf(ss * (1.0f / D) + 1e-6f);
#pragma unroll
            for (int i = 0; i < 4; ++i) { const f32x4 g = gq[i];
#pragma unroll
                for (int e = 0; e < 4; ++e) x[i][e] += yv[i][e] * rs * g[e];
                *(f32x4*)(xout + (size_t)r * D + i * 256 + lane * 4) = x[i]; }
        }
        if (hout) {
            float ss = 0.f;
#pragma unroll
            for (int i = 0; i < 4; ++i)
#pragma unroll
                for (int e = 0; e < 4; ++e) ss += x[i][e] * x[i][e];
            ss = wave_sum_dpp(ss);
            const float rs = rsqrtf(ss * (1.0f / D) + 1e-6f);
#pragma unroll
            for (int i = 0; i < 4; ++i) { const f32x4 g = gp[i];
                u32x2 w; w.x = cvt_pk_bf16(x[i][0] * rs * g[0], x[i][1] * rs * g[1]); w.y = cvt_pk_bf16(x[i][2] * rs * g[2], x[i][3] * rs * g[3]);
                *(u32x2*)(hout + (size_t)r * D + i * 256 + lane * 4) = w; }
        }
    }
}

__device__ __forceinline__ void pool_phase(const bf16_t* zp, bf16_t* pooled) {
    const size_t total = (size_t)TH * 64, stride = (size_t)gridDim.x * 512;
    for (size_t i = (size_t)blockIdx.x * 512 + opaque_tid(); i < total; i += stride) {
        const int tok = (int)(i >> 6), c8 = (int)(i & 63), t = tok & (SEQ - 1);
        const int win = 2 << (c8 >> 4); const int n = (t + 1) < win ? (t + 1) : win;
        float s[8], self[8];
        unpack8(*(const u32x4*)(zp + (size_t)tok * 512 + c8 * 8), self);
#pragma unroll
        for (int e = 0; e < 8; ++e) s[e] = self[e];
        for (int j = 1; j < n; ++j) { float v[8]; unpack8(*(const u32x4*)(zp + (size_t)(tok - j) * 512 + c8 * 8), v);
#pragma unroll
            for (int e = 0; e < 8; ++e) s[e] += v[e]; }
        const float inv = 1.0f / (float)n;
#pragma unroll
        for (int e = 0; e < 8; ++e) s[e] = s[e] * inv - self[e];
        *(u32x4*)(pooled + (size_t)tok * 512 + c8 * 8) = pack8(s);
    }
}

__device__ __forceinline__ void prep_phase(const bf16_t* zrkv  , const bf16_t* zl, const float* mu, bf16_t* rl, bf16_t* kl, bf16_t* vl, bf16_t* Al, const float* k_k, float* kinv) {
    constexpr int STRIP = 32;
    const int items = 416 * (TH / STRIP), stride = (int)gridDim.x * 512;
    for (int it = (int)blockIdx.x * 512 + opaque_tid(); it < items; it += stride) {
        const int ci = it % 416, strip = it / 416, c = ci * 8, tok0 = strip * STRIP, t0 = tok0 & (SEQ - 1);
        const bf16_t* src; bf16_t* dst; int ld;
        if (c < 3072) { const int arr = c >> 10, cc = c & 1023; src = zrkv + (size_t)arr * TH * 1024 + cc; ld = 1024; dst = (arr == 0 ? rl : (arr == 1 ? kl : vl)) + cc; }
        else { src = zl + (c - 3072); ld = 256; dst = Al + (c - 3072); }
        const bool isk = c >= 1024 && c < 2048; const int cc = isk ? c - 1024 : 0, cl = c - 3072;
        float m[8], kq[8];
        { const f32x4 m0 = *(const f32x4*)(mu + c), m1 = *(const f32x4*)(mu + c + 4), q0 = *(const f32x4*)(k_k + cc), q1 = *(const f32x4*)(k_k + cc + 4);
#pragma unroll
          for (int e = 0; e < 4; ++e) { m[e] = m0[e]; m[4 + e] = m1[e]; kq[e] = q0[e]; kq[4 + e] = q1[e]; } }
        float zp[8];
        if (t0 > 0) unpack8(*(const u32x4*)(src + (size_t)(tok0 - 1) * ld), zp);
        else {
#pragma unroll
            for (int e = 0; e < 8; ++e) zp[e] = 0.f;
        }
#pragma unroll 4
        for (int i = 0; i < STRIP; ++i) {
            const size_t tok = (size_t)(tok0 + i);
            float z[8], o[8];
            unpack8(*(const u32x4*)(src + tok * ld), z);
            float ss = 0.f;
#pragma unroll
            for (int e = 0; e < 8; ++e) { o[e] = z[e] + (zp[e] - z[e]) * m[e]; zp[e] = z[e]; const float kk = o[e] * kq[e]; ss += kk * kk; }
            ss = sum8(ss);
            if (isk && (ci & 7) == 0) kinv[tok * 16 + (cc >> 6)] = rsqrtf(ss + 1e-12f);
            if (cl >= 0) {
                if (cl < 64) {
#pragma unroll
                    for (int e = 0; e < 8; ++e) o[e] = tanhf_(o[e]);
                } else if (cl >= 128) {
#pragma unroll
                    for (int e = 0; e < 8; ++e) o[e] = sigmoidf_(o[e]);
                }
            }
            *(u32x4*)(dst + tok * ld) = pack8(o);
        }
    }
}

__device__ __forceinline__ void attn_phase(LAS unsigned char* lds, bf16_t* zq, const bf16_t* Kmem, const bf16_t* Vt, int half) {
    LAS bf16_t* Ks = (LAS bf16_t*)lds;
    LAS bf16_t* Vs = (LAS bf16_t*)(lds + 256 * 136 * 2);
    const int tid = opaque_tid(), wid = tid >> 6, lane = tid & 63, fr = lane & 15, fq = lane >> 4;
    for (int it0 = blockIdx.x; it0 < 256; it0 += gridDim.x) {
        const int item = ((it0 & 7) << 5) | (it0 >> 3);
        const int bl = item >> 6, h = (item >> 4) & 3, qt = item & 15, gb = half * 4 + bl;
#pragma unroll
        for (int i = 0; i < 8; ++i) { const int ch = tid + i * 512, m = ch >> 4, d8 = (ch & 15) * 8;
            *(LAS u32x4*)(Ks + m * 136 + d8) = *(const u32x4*)(Kmem + (size_t)(gb * 256 + m) * 512 + h * 128 + d8); }
#pragma unroll
        for (int i = 0; i < 8; ++i) { const int ch = tid + i * 512, d = ch >> 5, m8 = (ch & 31) * 8;
            *(LAS u32x4*)(Vs + d * 264 + m8) = *(const u32x4*)(Vt + (size_t)(h * 128 + d) * 2048 + gb * 256 + m8); }
        __syncthreads();
        const size_t tok = (size_t)bl * SEQ + qt * 128 + wid * 16 + fr;
        bf16_t* qp = zq + tok * 512 + h * 128;
        bf16x8 q[4];
#pragma unroll
        for (int ks = 0; ks < 4; ++ks) q[ks] = *(const bf16x8*)(qp + ks * 32 + fq * 8);
        f32x4 sacc[16];
#pragma unroll
        for (int n = 0; n < 16; ++n) sacc[n] = (f32x4){0.f, 0.f, 0.f, 0.f};
#pragma unroll
        for (int n = 0; n < 16; ++n)
#pragma unroll
            for (int ks = 0; ks < 4; ++ks) { const bf16x8 kf = *(const LAS bf16x8*)(Ks + (16 * n + fr) * 136 + ks * 32 + fq * 8);
                sacc[n] = __builtin_amdgcn_mfma_f32_16x16x32_bf16(kf, q[ks], sacc[n], 0, 0, 0); }
        float mx = -3.0e38f;
#pragma unroll
        for (int n = 0; n < 16; ++n)
#pragma unroll
            for (int e = 0; e < 4; ++e) mx = fmaxf(mx, sacc[n][e]);
        mx = fmaxf(mx, __shfl_xor(mx, 16)); mx = fmaxf(mx, __shfl_xor(mx, 32));
        const float sc = 0.08838834764831845f;
        float sum = 0.f;
#pragma unroll
        for (int n = 0; n < 16; ++n)
#pragma unroll
            for (int e = 0; e < 4; ++e) { const float pz = __expf((sacc[n][e] - mx) * sc); sacc[n][e] = pz; sum += pz; }
        sum += __shfl_xor(sum, 16); sum += __shfl_xor(sum, 32);
        f32x4 oacc[8];
#pragma unroll
        for (int n = 0; n < 8; ++n) oacc[n] = (f32x4){0.f, 0.f, 0.f, 0.f};
#pragma unroll
        for (int kk = 0; kk < 8; ++kk) {
            u32x4 pw; pw.x = cvt_pk_bf16(sacc[2 * kk][0], sacc[2 * kk][1]); pw.y = cvt_pk_bf16(sacc[2 * kk][2], sacc[2 * kk][3]);
            pw.z = cvt_pk_bf16(sacc[2 * kk + 1][0], sacc[2 * kk + 1][1]); pw.w = cvt_pk_bf16(sacc[2 * kk + 1][2], sacc[2 * kk + 1][3]);
            const bf16x8 pf = __builtin_bit_cast(bf16x8, pw);
#pragma unroll
            for (int n = 0; n < 8; ++n) {
                const u32x2 v0 = *(const LAS u32x2*)(Vs + (16 * n + fr) * 264 + 32 * kk + 4 * fq), v1 = *(const LAS u32x2*)(Vs + (16 * n + fr) * 264 + 32 * kk + 16 + 4 * fq);
                u32x4 vw; vw.x = v0.x; vw.y = v0.y; vw.z = v1.x; vw.w = v1.y;
                oacc[n] = __builtin_amdgcn_mfma_f32_16x16x32_bf16(__builtin_bit_cast(bf16x8, vw), pf, oacc[n], 0, 0, 0);
            }
        }
        const float inv = 1.0f / sum;
#pragma unroll
        for (int n = 0; n < 8; ++n) { u32x2 w; w.x = cvt_pk_bf16(oacc[n][0] * inv, oacc[n][1] * inv); w.y = cvt_pk_bf16(oacc[n][2] * inv, oacc[n][3] * inv);
            *(u32x2*)(qp + 16 * n + 4 * fq) = w; }
        __syncthreads();
    }
}

struct ScanRaw { u32x2 r, k, v, om, a; float inv; };
typedef float f32x2 __attribute__((ext_vector_type(2)));
__device__ __forceinline__ void scan_bar() { asm volatile("s_waitcnt lgkmcnt(0)\n\ts_barrier" ::: "memory"); }
__device__ __forceinline__ void unpack4(const u32x2 w, float (&v)[4]) { v[0] = bf_lo(w.x); v[1] = bf_hi(w.x); v[2] = bf_lo(w.y); v[3] = bf_hi(w.y); }
__device__ __forceinline__ void unpack4h(const u32x2 w, float (&v)[4]) {
    typedef _Float16 h2 __attribute__((ext_vector_type(2)));
    const unsigned w0 = w.x, w1 = w.y; const h2 a = __builtin_bit_cast(h2, w0), b = __builtin_bit_cast(h2, w1);
    v[0] = (float)a.x; v[1] = (float)a.y; v[2] = (float)b.x; v[3] = (float)b.y;
}
__device__ __forceinline__ void scan_phase(LAS unsigned char* lds, const bf16_t* rl, const bf16_t* kl, const bf16_t* vl, const bf16_t* omw, const bf16_t* aa, const float* kinv, bf16_t* y, const float* k_k, const float* k_a) {
    constexpr int CH = 32, REC = 320, NC = SEQ / CH, YB = (CH / 4) * 16 * 17 * 4;
    LAS float* bufs = (LAS float*)lds;
    LAS float* yp = (LAS float*)(lds + 2 * CH * REC * 4);
    LAS float* vb = yp + 2 * YB;
    const int tid = opaque_tid();
    const bool loader = tid >= 256;
    for (int it0 = blockIdx.x; it0 < 256; it0 += gridDim.x) {
        const int item = ((it0 & 7) << 5) | (it0 >> 3);
        const int bh = item >> 2, rg = item & 3, bl = bh >> 4, head = bh & 15;
        const size_t tok0 = (size_t)bl * SEQ; const int ch0 = head * 64;
        const int lt = tid & 255, ls = lt >> 4, cg4 = lt & 15, lc = ch0 + cg4 * 4;
        const int ys = lt >> 4, yrow = lt & 15;
        float kkc[4], kac[4];
#pragma unroll
        for (int e = 0; e < 4; ++e) { kkc[e] = k_k[lc + e]; kac[e] = k_a[lc + e]; }
        auto load_raw = [&](int chunk, int sub) { ScanRaw raw; const size_t tk = tok0 + (size_t)chunk * CH + ls + 16 * sub, idx = tk * 1024 + lc;
            raw.r = *(const u32x2*)(rl + idx); raw.k = *(const u32x2*)(kl + idx); raw.v = *(const u32x2*)(vl + idx); raw.om = *(const u32x2*)(omw + idx); raw.a = *(const u32x2*)(aa + idx);
            raw.inv = kinv[tk * 16 + head]; return raw; };
        ScanRaw rw0, rw1, rw2, rx0, rx1, rx2;
        auto prep_store = [&](LAS float* b, LAS float* vbuf, const ScanRaw& raw, int sub) {
            const int ls = (lt >> 4) + 16 * sub;
            float r[4], k[4], v[4], om[4], a[4];
            unpack4(raw.r, r); unpack4(raw.k, k); unpack4(raw.v, v); unpack4h(raw.om, om); unpack4h(raw.a, a);
            f32x4 an, w, bn, ke, rr, vv;
#pragma unroll
            for (int e = 0; e < 4; ++e) { const float kk = k[e] * (kkc[e] * raw.inv); an[e] = -kk; w[e] = 1.0f - om[e]; bn[e] = kk * a[e]; ke[e] = k[e] * (1.0f + (a[e] - 1.0f) * kac[e]); rr[e] = r[e]; vv[e] = v[e]; }
            LAS float* rec = b + ls * REC + cg4 * 4;
            *(LAS f32x4*)(rec) = an; *(LAS f32x4*)(rec + 64) = w; *(LAS f32x4*)(rec + 128) = bn; *(LAS f32x4*)(rec + 192) = ke; *(LAS f32x4*)(rec + 256) = rr;
            if ((cg4 >> 2) == rg) { LAS float* vd = vbuf + ((cg4 & 3) * 4) * CH + ls; vd[0] = vv[0]; vd[CH] = vv[1]; vd[2 * CH] = vv[2]; vd[3 * CH] = vv[3]; }
        };
        auto write_y = [&](int chunk) {
            if (lt < 16 * (CH / 4)) {
                const int g4 = lt >> 4, yrow4 = lt & 15;
                const LAS float* pp = yp + (chunk & 1) * YB + (g4 * 16 + yrow4) * 17 * 4;
                f32x4 t4 = *(const LAS f32x4*)(pp);
#pragma unroll
                for (int i = 1; i < 16; ++i) t4 += *(const LAS f32x4*)(pp + 4 * i);
                bf16_t* yd = y + (tok0 + (size_t)chunk * CH + 4 * g4) * 1024 + ch0 + rg * 16 + yrow4;
#pragma unroll
                for (int j = 0; j < 4; ++j) yd[(size_t)j * 1024] = (bf16_t)(cvt_pk_bf16(t4[j], 0.f) & 0xffffu);
            } };
        const int l = tid & 63, rloc = ((tid >> 6) & 3) * 4 + (l >> 4), c4 = (l & 15) * 4;
        f32x2 S01 = (f32x2){0.f, 0.f}, S23 = (f32x2){0.f, 0.f};

        if (loader) { rw0 = load_raw(0, 0); rx0 = load_raw(0, 1); prep_store(bufs, vb, rw0, 0); prep_store(bufs, vb, rx0, 1);
            rw0 = load_raw(1, 0); rx0 = load_raw(1, 1); rw1 = load_raw(2, 0); rx1 = load_raw(2, 1); rw2 = load_raw(3, 0); rx2 = load_raw(3, 1); }
        scan_bar();
        for (int c = 0; c < NC; ++c) {
            if (loader) {
                if (c + 1 < NC) { prep_store(bufs + ((c + 1) & 1) * (CH * REC), vb + ((c + 1) & 1) * (16 * CH), rw0, 0); prep_store(bufs + ((c + 1) & 1) * (CH * REC), vb + ((c + 1) & 1) * (16 * CH), rx0, 1); }
                rw0 = rw1; rw1 = rw2; rx0 = rx1; rx1 = rx2;
                if (c + 4 < NC) { rw2 = load_raw(c + 4, 0); rx2 = load_raw(c + 4, 1); }
                if (c >= 1) write_y(c - 1);
            } else {
                if ((tid >> 6) & 1) __builtin_amdgcn_s_sleep(1);
                LAS float* b = bufs + (c & 1) * (CH * REC);
                LAS float* yo = yp + (c & 1) * YB + (rloc * 17 + (l & 15)) * 4;
                f32x4 an = *(LAS f32x4*)(b + c4), w = *(LAS f32x4*)(b + 64 + c4), bn = *(LAS f32x4*)(b + 128 + c4), kx = *(LAS f32x4*)(b + 192 + c4), rr = *(LAS f32x4*)(b + 256 + c4);
                f32x4 v4[CH / 4];
#pragma unroll
                for (int g = 0; g < CH / 4; ++g) v4[g] = *(LAS f32x4*)(vb + (c & 1) * (16 * CH) + rloc * CH + 4 * g);
                f32x4 yq;
#pragma unroll
                for (int s = 0; s < CH; ++s) {
                    const f32x4 an_ = an, w_ = w, bn_ = bn, k_ = kx, r_ = rr; const float v_ = v4[s >> 2][s & 3];
                    if (s + 1 < CH) { LAS float* nb = b + (s + 1) * REC;
                        an = *(LAS f32x4*)(nb + c4); w = *(LAS f32x4*)(nb + 64 + c4); bn = *(LAS f32x4*)(nb + 128 + c4); kx = *(LAS f32x4*)(nb + 192 + c4); rr = *(LAS f32x4*)(nb + 256 + c4); }
                    f32x2 p2 = S01 * (f32x2){an_[0], an_[1]}; p2 = S23 * (f32x2){an_[2], an_[3]} + p2;
                    float sa = p2[0] + p2[1];
                    const f32x2 vv2 = (f32x2){v_, v_};
                    const f32x2 t01 = S01 * (f32x2){w_[0], w_[1]} + (f32x2){k_[0], k_[1]} * vv2, t23 = S23 * (f32x2){w_[2], w_[3]} + (f32x2){k_[2], k_[3]} * vv2;
                    sa = row16_sum(sa);
                    const f32x2 sa2 = (f32x2){sa, sa};
                    S01 = (f32x2){bn_[0], bn_[1]} * sa2 + t01; S23 = (f32x2){bn_[2], bn_[3]} * sa2 + t23;
                    f32x2 q2 = S01 * (f32x2){r_[0], r_[1]}; q2 = S23 * (f32x2){r_[2], r_[3]} + q2;
                    yq[s & 3] = q2[0] + q2[1];
                    if ((s & 3) == 3) *(LAS f32x4*)(yo + (s >> 2) * (16 * 17 * 4)) = yq;
                }
            }
            scan_bar();
        }
        if (loader) write_y(NC - 1);
        scan_bar();
    }
}

__device__ __forceinline__ void post_phase(bf16_t* y, const bf16_t* rl, const bf16_t* kl, const bf16_t* vl, const bf16_t* aa, const bf16_t* gg, const float* k_a, const float* r_k, const float* lnw, const float* lnb) {
    constexpr int STRIP = 8;
    const int items = 128 * (TH / STRIP), stride = (int)gridDim.x * 512;
    for (int it = (int)blockIdx.x * 512 + opaque_tid(); it < items; it += stride) {
        int c = (it & 127) * 8; size_t tok0 = (size_t)(it >> 7) * STRIP;
        if (gridDim.x == 256) {
            const int x = (int)blockIdx.x & 7, g = ((int)blockIdx.x >> 3) * 512 + (it & 511);
            c = (x & 1) * 512 + (g & 63) * 8; tok0 = (size_t)(x >> 1) * SEQ + (size_t)(g >> 6) * STRIP;
        }
        float ka[8], rk[8], lw[8], lb[8];
        { const f32x4 a0 = *(const f32x4*)(k_a + c), a1 = *(const f32x4*)(k_a + c + 4), b0 = *(const f32x4*)(r_k + c), b1 = *(const f32x4*)(r_k + c + 4),
                      c0 = *(const f32x4*)(lnw + c), c1 = *(const f32x4*)(lnw + c + 4), d0 = *(const f32x4*)(lnb + c), d1 = *(const f32x4*)(lnb + c + 4);
#pragma unroll
          for (int e = 0; e < 4; ++e) { ka[e] = a0[e]; ka[4 + e] = a1[e]; rk[e] = b0[e]; rk[4 + e] = b1[e]; lw[e] = c0[e]; lw[4 + e] = c1[e]; lb[e] = d0[e]; lb[4 + e] = d1[e]; } }
#pragma unroll 2
        for (int i = 0; i < STRIP; ++i) {
            const size_t idx = (tok0 + i) * 1024 + c;
            float yv[8], r[8], k[8], v[8], a[8], g[8];
            unpack8(*(const u32x4*)(y + idx), yv); unpack8(*(const u32x4*)(rl + idx), r); unpack8(*(const u32x4*)(kl + idx), k); unpack8(*(const u32x4*)(vl + idx), v);
            unpack8h(*(const u32x4*)(aa + idx), a); unpack8(*(const u32x4*)(gg + idx), g);
            float s = 0.f, dot = 0.f;
#pragma unroll
            for (int e = 0; e < 8; ++e) { s += yv[e]; dot += r[e] * k[e] * (1.0f + (a[e] - 1.0f) * ka[e]) * rk[e]; }
            s = sum8(s); dot = sum8(dot);
            const float mu = s * (1.0f / 64.0f);
            float q = 0.f;
#pragma unroll
            for (int e = 0; e < 8; ++e) { const float d = yv[e] - mu; q += d * d; }
            q = sum8(q);
            const float rs = rsqrtf(q * (1.0f / 64.0f) + 64e-5f);
#pragma unroll
            for (int e = 0; e < 8; ++e) yv[e] = (((yv[e] - mu) * rs) * lw[e] + lb[e] + dot * v[e]) * g[e];
            *(u32x4*)(y + idx) = pack8(yv);
        }
    }
}

__device__ __forceinline__ void conv_phase(const bf16_t* u, bf16_t* fin, const float* cw, const float* cb) {
    constexpr int STRIP = 32;
    const int items = 352 * (TH / STRIP), stride = (int)gridDim.x * 512;
    for (int it = (int)blockIdx.x * 512 + opaque_tid(); it < items; it += stride) {
        const int chunk = it % 352, strip = it / 352, n = chunk * 8, tok0 = strip * STRIP, t0 = tok0 & (SEQ - 1);
        float wg[3][8], wv[3][8], bg[8], bv[8];
#pragma unroll
        for (int j = 0; j < 3; ++j) {
            const f32x4 a0 = *(const f32x4*)(cw + j * 2 * DFF + n), a1 = *(const f32x4*)(cw + j * 2 * DFF + n + 4), b0 = *(const f32x4*)(cw + j * 2 * DFF + DFF + n), b1 = *(const f32x4*)(cw + j * 2 * DFF + DFF + n + 4);
#pragma unroll
            for (int e = 0; e < 4; ++e) { wg[j][e] = a0[e]; wg[j][4 + e] = a1[e]; wv[j][e] = b0[e]; wv[j][4 + e] = b1[e]; }
        }
        {
            const f32x4 a0 = *(const f32x4*)(cb + n), a1 = *(const f32x4*)(cb + n + 4), b0 = *(const f32x4*)(cb + DFF + n), b1 = *(const f32x4*)(cb + DFF + n + 4);
#pragma unroll
            for (int e = 0; e < 4; ++e) { bg[e] = a0[e]; bg[4 + e] = a1[e]; bv[e] = b0[e]; bv[4 + e] = b1[e]; }
        }
        float g2[8], v2[8], g1[8], v1[8];
        if (t0 >= 2) {
            unpack8(*(const u32x4*)(u + (size_t)(tok0 - 2) * (2 * DFF) + n), g2); unpack8(*(const u32x4*)(u + (size_t)(tok0 - 2) * (2 * DFF) + DFF + n), v2);
            unpack8(*(const u32x4*)(u + (size_t)(tok0 - 1) * (2 * DFF) + n), g1); unpack8(*(const u32x4*)(u + (size_t)(tok0 - 1) * (2 * DFF) + DFF + n), v1);
        } else {
#pragma unroll
            for (int e = 0; e < 8; ++e) { g2[e] = 0.f; v2[e] = 0.f; g1[e] = 0.f; v1[e] = 0.f; }
        }
#pragma unroll 4
        for (int i = 0; i < STRIP; ++i) {
            const size_t tok = (size_t)(tok0 + i);
            float g0[8], v0[8], o[8];
            unpack8(*(const u32x4*)(u + tok * (2 * DFF) + n), g0); unpack8(*(const u32x4*)(u + tok * (2 * DFF) + DFF + n), v0);
#pragma unroll
            for (int e = 0; e < 8; ++e) {
                const float x = bg[e] + wg[0][e] * g2[e] + wg[1][e] * g1[e] + wg[2][e] * g0[e];
                const float vv = bv[e] + wv[0][e] * v2[e] + wv[1][e] * v1[e] + wv[2][e] * v0[e];
                o[e] = x * sigmoidf_(1.5957691216f * (x + 0.044715f * x * x * x)) * vv;
                g2[e] = g1[e]; g1[e] = g0[e]; v2[e] = v1[e]; v1[e] = v0[e];
            }
            *(u32x4*)(fin + tok * DFF + n) = pack8(o);
        }
    }
}

#define XB_TMO      128
#define XB_XCNT(j)  (256  + 64 * (j))
#define XB_XSUB(j)  (1280 + 64 * (j))
#define XB_XGEN(j)  (2304 + 64 * (j))
#define XB_TOP      3328
#define XB_TOPGEN   3392
#define XCD_BAR_WORDS 3456
#define XB_SPIN_CAP (1u << 18)
__device__ __forceinline__ unsigned xb_ld(unsigned* p)              { return __hip_atomic_load(p, __ATOMIC_RELAXED, __HIP_MEMORY_SCOPE_AGENT); }
__device__ __forceinline__ unsigned xb_add(unsigned* p, unsigned v) { return __hip_atomic_fetch_add(p, v, __ATOMIC_RELAXED, __HIP_MEMORY_SCOPE_AGENT); }
__device__ __forceinline__ unsigned xb_xcc_id() { return (unsigned)__builtin_amdgcn_s_getreg((3 << 11) | 20) & 0xFu; }
#define XB_SPIN(cond, bar) do { unsigned _sp = 0; while (cond) { __builtin_amdgcn_s_sleep(1); \
    if ((++_sp & 255u) == 0u) { if (xb_ld(&(bar)[XB_TMO])) break; if (_sp > XB_SPIN_CAP) { atomicAdd(&(bar)[XB_TMO], 1u); break; } } } } while (0)
struct XcdBarrier { unsigned* bar; unsigned x; volatile LAS unsigned* st; };
__device__ __forceinline__ XcdBarrier xcd_barrier_post(unsigned* bar, volatile LAS unsigned* st) {
    XcdBarrier b; b.bar = bar; b.x = xb_xcc_id(); b.st = st;
    if (threadIdx.x == 0) (void)xb_add(&bar[XB_XCNT(b.x)], 1u);
    return b;
}
__device__ __forceinline__ void xcd_barrier_complete(unsigned* bar, unsigned x, unsigned& nloc, unsigned& nx) {
    const unsigned G = gridDim.x * gridDim.y * gridDim.z;
    unsigned sum, cnt, mine, sp = 0u;
    for (;;) {
        sum = 0u; cnt = 0u; mine = 0u;
#pragma unroll
        for (unsigned j = 0; j < 16; ++j) { const unsigned c = xb_ld(&bar[XB_XCNT(j)]); sum += c; cnt += (c > 0u) ? 1u : 0u; mine = (j == x) ? c : mine; }
        if (sum == G) break;
        __builtin_amdgcn_s_sleep(1);
        if ((++sp & 255u) == 0u) { if (xb_ld(&bar[XB_TMO])) break; if (sp > XB_SPIN_CAP) { atomicAdd(&bar[XB_TMO], 1u); break; } }
    }
    nloc = mine > 0u ? mine : 1u; nx = cnt > 0u ? cnt : 1u;
}
__device__ __forceinline__ void xcd_barrier(const XcdBarrier& b) {
    asm volatile("s_waitcnt vmcnt(0)" ::: "memory");
    __syncthreads();
    if (threadIdx.x == 0) {
        unsigned* bar = b.bar;
        __builtin_amdgcn_s_waitcnt(0);
        unsigned nloc = b.st[0], nx = b.st[1];
        if (nloc == 0u) { xcd_barrier_complete(bar, b.x, nloc, nx); b.st[0] = nloc; b.st[1] = nx; }
        const unsigned old = xb_add(&bar[XB_XSUB(b.x)], 1u);
        const unsigned gen = old / nloc;
        if (old + 1u == (gen + 1u) * nloc) {
            __builtin_amdgcn_fence(__ATOMIC_RELEASE, "agent");
            asm volatile("s_waitcnt vmcnt(0)" ::: "memory");
            const unsigned og = xb_add(&bar[XB_TOP], 1u);
            const unsigned tg = og / nx;
            if (og + 1u == (tg + 1u) * nx) xb_add(&bar[XB_TOPGEN], 1u);
            else XB_SPIN(xb_ld(&bar[XB_TOPGEN]) == tg, bar);
            __builtin_amdgcn_fence(__ATOMIC_ACQUIRE, "agent");
            xb_add(&bar[XB_XGEN(b.x)], 1u);
            asm volatile("s_waitcnt vmcnt(0)" ::: "memory");
        } else {
            XB_SPIN(xb_ld(&bar[XB_XGEN(b.x)]) == gen, bar);
            __builtin_amdgcn_fence(__ATOMIC_ACQUIRE, "agent");
            asm volatile("s_waitcnt vmcnt(0)" ::: "memory");
        }
    }
    __syncthreads();
}
constexpr size_t WS_BAR = 254 * MiB;

__global__ void __launch_bounds__(512, 2) fwd_megakernel(Params p) {
    extern __shared__ __attribute__((aligned(16))) unsigned char shm[];
    LAS unsigned char* lds = (LAS unsigned char*)shm;
    cg::grid_group grid = cg::this_grid();
    volatile LAS unsigned* xst = (volatile LAS unsigned*)(lds + DYN_LDS - 16);
    if (threadIdx.x == 0) { xst[0] = 0u; xst[1] = 0u; }
    if (blockIdx.x == 0) for (int i = threadIdx.x; i < XCD_BAR_WORDS; i += 512) ((unsigned*)(p.ws + WS_BAR))[i] = 0u;
    __syncthreads();
    XcdBarrier xbar; xbar.bar = (unsigned*)(p.ws + WS_BAR); xbar.x = xb_xcc_id(); xbar.st = xst;
    auto wsp = [&](size_t off) -> bf16_t* { size_t o = off; asm volatile("" : "+s"(o)); return (bf16_t*)(p.ws + o); };
#define HBUF wsp(WS_H)
#define POOLED wsp(WS_H)
#define AL wsp(WS_H + 8 * MiB)
#define VD wsp(WS_H + 12 * MiB)
#define ZP wsp(WS_ZP)
#define ZQ wsp(WS_ZQ)
#define ZR wsp(WS_ZR)
#define ZK wsp(WS_ZK)
#define ZV wsp(WS_ZV)
#define ZL wsp(WS_ZL)
#define GATES wsp(WS_GATES)
#define RL wsp(WS_RL)
#define KL wsp(WS_KL)
#define WT(off) ((const bf16_t*)wsp(WS_W + (off)))

    for (int l = 0; l < 2; ++l) {
        row_phase(p.mem, nullptr, nullptr, nullptr, p.mem_norm, wsp(WS_MEMN), 2048);
        cvt_mixer(lds, p, l);
        row_phase(l == 0 ? p.x : p.out, nullptr, nullptr, nullptr, p.norm_mix_pre + l * D, HBUF, TH);
        if (l == 0) { grid.sync(); if (threadIdx.x == 0) (void)xb_add(&xbar.bar[XB_XCNT(xbar.x)], 1u); }
        else xcd_barrier(xbar);
        for (int hb = 0; hb < 2; ++hb) {
            const size_t xoff = (size_t)hb * TH * D;
            const float* xin = (l == 0 ? p.x : p.out) + xoff;
            const size_t vf_off = WS_VFIRST + xoff * 2, vl_off = l == 0 ? vf_off : WS_VL;
            run_gemm(lds, HBUF, WT(W_IN), TH, INC, 1024, mk_epi(EM_Z, ZP, 0, p.gate_b + (size_t)l * 3 * D));
            if (hb == 0) {
                const int G = (int)gridDim.x, nz = (TH / 256) * (INC / 256), f0 = nz % G < G - 32 ? nz % G : 0;
                run_gemm_on(lds, wsp(WS_MEMN), WT(W_K), 2048, 512, 1024, mk_epi(EM_PLAIN, wsp(WS_KMEM), 512), f0, 16);
                run_gemm_on(lds, WT(W_V), wsp(WS_MEMN), 512, 2048, 1024, mk_epi(EM_PLAIN, wsp(WS_VT), 2048), f0 + 16, G - f0 - 16);
            }
            xcd_barrier(xbar);
            pool_phase(ZP, POOLED);
            prep_phase(ZR, ZL, p.mu_shift + (size_t)l * RWC, RL, KL, wsp(vl_off), AL, p.k_k + l * D, (float*)wsp(WS_KINV));
            attn_phase(lds, ZQ, wsp(WS_KMEM), wsp(WS_VT), hb);
            xcd_barrier(xbar);
            {
                const int G = (int)gridDim.x, nv = l > 0 ? G / 8 : 0, np = G / 4, nl = G - np - nv;
                run_gemm_on(lds, AL, WT(W_LORA), TH, 3072, 256, mk_epi(EM_LORA, ZR, 1024, p.w0 + l * D, p.a0 + l * D), 0, nl);
                run_gemm_on(lds, POOLED, WT(W_POOL), TH, 512, 512, mk_epi(EM_POOLW, ZP, 512, p.pool_b + l * 512, p.pool_scale + l * 512), nl, np);
                if (l > 0) run_gemm_on(lds, wsp(vl_off), WT(W_DOWN), TH, 256, 1024, mk_epi(EM_PLAIN, VD, 256), nl + np, nv);
            }
            xcd_barrier(xbar);
            if (l > 0) {
                run_gemm(lds, VD, WT(W_UP), TH, 1024, 256, mk_epi(EM_VUP, wsp(vl_off), 1024, p.v0 + (size_t)(l - 1) * D, nullptr, wsp(vf_off)));
                xcd_barrier(xbar);
            }
            scan_phase(lds, RL, KL, wsp(vl_off), ZR  , ZK  , (const float*)wsp(WS_KINV), HBUF, p.k_k + l * D, p.k_a + l * D);
            xcd_barrier(xbar);
            post_phase(HBUF, RL, KL, wsp(vl_off), ZK  , ZV  , p.k_a + l * D, p.r_k + l * D, p.ln_x_w + l * D, p.ln_x_b + l * D);
            xcd_barrier(xbar);
            {
                const int G = (int)gridDim.x, h0 = G / 2;
                run_gemm_on(lds, ZP, WT(W_PP), TH, 1024, 512, mk_epi(EM_MERGE, ZR  , 1024, nullptr, nullptr, GATES, 0, 0), 0, h0);
                run_gemm_on(lds, ZQ, WT(W_PM), TH, 1024, 512, mk_epi(EM_MERGE, ZR, 1024, nullptr, nullptr, GATES, 2, 1), 0, h0);
                run_gemm_on(lds, HBUF, WT(W_PR), TH, 1024, 1024, mk_epi(EM_MERGE, ZV  , 1024, nullptr, nullptr, GATES, 1, 0), h0, G - h0);
                xcd_barrier(xbar);
                run_gemm_on(lds, ZR, WT(W_O), TH, 1024, 1024, mk_epi(EM_PLAIN, ZK  , 1024), 0, h0);
                run_gemm_on(lds, ZV, WT(W_O), TH, 1024, 1024, mk_epi(EM_PLAIN, RL  , 1024), h0, G - h0);
                xcd_barrier(xbar);
            }
            row_phase(xin, ZK, p.norm_mix_post + l * D, p.out + xoff, nullptr, nullptr, TH, RL);
            if (hb == 0) row_phase((l == 0 ? p.x : p.out) + (size_t)TH * D, nullptr, nullptr, nullptr, p.norm_mix_pre + l * D, HBUF, TH);
            if (hb == 1) { cvt_ffn(lds, p, l); row_phase(p.out, nullptr, nullptr, nullptr, p.norm_ffn_pre + l * D, wsp(WS_H2), TH); }
            xcd_barrier(xbar);
        }
        for (int hb = 0; hb < 2; ++hb) {
            run_gemm(lds, wsp(WS_H2), WT(W_FU), TH, 2 * DFF, 1024, mk_epi(EM_PLAIN, wsp(WS_URAW), 2 * DFF));
            xcd_barrier(xbar);
            conv_phase(wsp(WS_URAW), wsp(WS_FIN) + (size_t)hb * TH * DFF, p.conv_w + (size_t)l * 3 * 2 * DFF, p.conv_b + (size_t)l * 2 * DFF);
            if (hb == 0) row_phase(p.out + (size_t)TH * D, nullptr, nullptr, nullptr, p.norm_ffn_pre + l * D, wsp(WS_H2), TH);
            xcd_barrier(xbar);
        }
        run_gemm(lds, wsp(WS_FIN), WT(W_FD), 2 * TH, 1024, DFF, mk_epi(EM_PLAIN, wsp(WS_F), 1024));
        xcd_barrier(xbar);
        row_phase(p.out, wsp(WS_F), p.norm_ffn_post + l * D, p.out, nullptr, nullptr, 2 * TH);
        if (l == 0) xcd_barrier(xbar);
    }
}

extern "C" void kernel_launch(void* const* d_in, const int* in_sizes, int n_in, void* d_out, int out_size, void* d_ws, size_t ws_size, hipStream_t stream) {
    static int grid_blocks = 0;
    if (!grid_blocks) {
        int dev = 0, cus = 0, per_cu = 0;
        hipGetDevice(&dev);
        hipDeviceGetAttribute(&cus, hipDeviceAttributeMultiprocessorCount, dev);
        hipFuncSetAttribute((const void*)fwd_megakernel, hipFuncAttributeMaxDynamicSharedMemorySize, DYN_LDS);
        hipOccupancyMaxActiveBlocksPerMultiprocessor(&per_cu, fwd_megakernel, 512, DYN_LDS);
        if (per_cu < 1) per_cu = 1;
        grid_blocks = cus * per_cu;
    }
    Params p{};
    const float** pp = (const float**)&p;
    for (int i = 0; i < 35; ++i) pp[i] = (const float*)d_in[i];
    p.out = (float*)d_out; p.ws = (unsigned char*)d_ws;
    void* args[] = {&p};
    hipError_t e = hipLaunchCooperativeKernel((void*)fwd_megakernel, dim3(grid_blocks), dim3(512), args, DYN_LDS, stream);
    if (e != hipSuccess) fprintf(stderr, "cooperative launch failed: %s (grid %d)\n", hipGetErrorString(e), grid_blocks);
}
```

```cpp
#include <hip/hip_runtime.h>
#include <hip/hip_cooperative_groups.h>
#include <cstdio>
namespace cg = cooperative_groups;

#define LAS __attribute__((address_space(3)))
typedef unsigned short bf16_t;
typedef short bf16x8 __attribute__((ext_vector_type(8)));
typedef float f32x4 __attribute__((ext_vector_type(4)));
typedef unsigned u32x4 __attribute__((ext_vector_type(4)));
typedef unsigned u32x2 __attribute__((ext_vector_type(2)));

constexpr int D = 1024, SEQ = 2048, TH = 8192  , DFF = 2816, INC = 7424, RWC = 3328;
constexpr size_t MiB = 1u << 20;
constexpr size_t WS_W = 0;
constexpr size_t W_IN = 0, W_POOL = 14 * MiB + MiB / 2, W_PP = 15 * MiB, W_K = 16 * MiB, W_V = 17 * MiB, W_PM = 18 * MiB, W_LORA = 19 * MiB,
                 W_DOWN = 20 * MiB + MiB / 2, W_UP = 21 * MiB, W_PR = 21 * MiB + MiB / 2, W_O = 23 * MiB + MiB / 2;
constexpr size_t W_FU = 0, W_FD = 11 * MiB;
constexpr size_t WS_MEMN = 26 * MiB, WS_KMEM = 30 * MiB, WS_VT = 32 * MiB, WS_VFIRST = 34 * MiB;
constexpr size_t WS_H = 66 * MiB;
constexpr size_t WS_ZP = 82 * MiB, WS_ZQ = 90 * MiB, WS_ZR = 98 * MiB, WS_ZK = 114 * MiB, WS_ZV = 130 * MiB, WS_ZL = 146 * MiB, WS_GATES = 150 * MiB;
constexpr size_t WS_RL = 198 * MiB, WS_KL = 214 * MiB, WS_VL = 230 * MiB;
constexpr size_t WS_H2 = 17 * MiB, WS_URAW = 66 * MiB, WS_FIN = 154 * MiB, WS_F = 66 * MiB;
constexpr size_t WS_KINV = 246 * MiB;
constexpr int DYN_LDS = 163840;

struct Params {
    const float *x, *mem, *mem_norm, *norm_mix_pre, *norm_mix_post, *w_in, *mu_shift, *pool_w, *pool_b, *pool_scale, *w_proj_pool, *w_mem_kv, *w_proj_mem, *w0, *w_up_decay,
        *a0, *w_up_a, *w_up_g, *k_k, *k_a, *r_k, *ln_x_w, *ln_x_b, *v0, *w_down_v, *w_up_v, *w_proj_rwkv, *gate_b, *w_o, *norm_ffn_pre, *norm_ffn_post, *w_ffn_up, *conv_w,
        *conv_b, *w_ffn_down;
    float* out;
    unsigned char* ws;
};

__device__ __forceinline__ unsigned cvt_pk_bf16(float lo, float hi) { unsigned r; asm("v_cvt_pk_bf16_f32 %0, %1, %2" : "=v"(r) : "v"(lo), "v"(hi)); return r; }
__device__ __forceinline__ float bf_lo(unsigned w) { return __uint_as_float(w << 16); }
__device__ __forceinline__ float bf_hi(unsigned w) { return __uint_as_float(w & 0xffff0000u); }
__device__ __forceinline__ void unpack8(const u32x4 w, float (&v)[8]) {
    v[0] = bf_lo(w.x); v[1] = bf_hi(w.x); v[2] = bf_lo(w.y); v[3] = bf_hi(w.y); v[4] = bf_lo(w.z); v[5] = bf_hi(w.z); v[6] = bf_lo(w.w); v[7] = bf_hi(w.w);
}
__device__ __forceinline__ u32x4 pack8(const float (&v)[8]) { u32x4 w; w.x = cvt_pk_bf16(v[0], v[1]); w.y = cvt_pk_bf16(v[2], v[3]); w.z = cvt_pk_bf16(v[4], v[5]); w.w = cvt_pk_bf16(v[6], v[7]); return w; }
__device__ __forceinline__ unsigned pk_h2(float a, float b) { typedef _Float16 h2 __attribute__((ext_vector_type(2))); h2 h; h.x = (_Float16)a; h.y = (_Float16)b; return __builtin_bit_cast(unsigned, h); }
__device__ __forceinline__ void unpack8h(const u32x4 w, float (&v)[8]) {
    typedef _Float16 h2 __attribute__((ext_vector_type(2)));
    const unsigned w0 = w.x, w1 = w.y, w2 = w.z, w3 = w.w;
    h2 a = __builtin_bit_cast(h2, w0), b = __builtin_bit_cast(h2, w1), c = __builtin_bit_cast(h2, w2), d = __builtin_bit_cast(h2, w3);
    v[0] = (float)a.x; v[1] = (float)a.y; v[2] = (float)b.x; v[3] = (float)b.y; v[4] = (float)c.x; v[5] = (float)c.y; v[6] = (float)d.x; v[7] = (float)d.y;
}
__device__ __forceinline__ float sigmoidf_(float x) { return __builtin_amdgcn_rcpf(1.0f + __expf(-x)); }
__device__ __forceinline__ float tanhf_(float x) { return 1.0f - 2.0f * __builtin_amdgcn_rcpf(1.0f + __expf(2.0f * x)); }
__device__ __forceinline__ float wave_sum(float v) {
#pragma unroll
    for (int o = 32; o >= 1; o >>= 1) v += __shfl_xor(v, o);
    return v;
}
__device__ __forceinline__ int opaque_tid() { int t = threadIdx.x; asm volatile("" : "+v"(t)); return t; }
template <int CTRL> __device__ __forceinline__ float dpp_f(float x) { return __int_as_float(__builtin_amdgcn_update_dpp(0, __float_as_int(x), CTRL, 0xF, 0xF, true)); }
__device__ __forceinline__ float row16_sum(float x) {
    x += dpp_f<0xB1>(x); x += dpp_f<0x4E>(x); x += dpp_f<0x141>(x); x += dpp_f<0x140>(x); return x;
}
__device__ __forceinline__ float sum8(float x) {
    x += dpp_f<0xB1>(x); x += dpp_f<0x4E>(x); x += dpp_f<0x141>(x); return x;
}
__device__ __forceinline__ float wave_sum_dpp(float x) {
    x = row16_sum(x);
    { const unsigned u = __float_as_uint(x); const auto r = __builtin_amdgcn_permlane16_swap(u, u, false, false); x = __uint_as_float(r[0]) + __uint_as_float(r[1]); }
    { const unsigned u = __float_as_uint(x); const auto r = __builtin_amdgcn_permlane32_swap(u, u, false, false); x = __uint_as_float(r[0]) + __uint_as_float(r[1]); }
    return x;
}

namespace pg8 {
constexpr int BM = 256, BK = 64, HALF = 128, HTB = HALF * BK * 2, STAGE_BYTES = 8 * HTB, NXCD = 8, WGM = 8;
__device__ __forceinline__ int lds_byte(int r, int c) { const int st = (r >> 4) * 2 + (c >> 5), rr = r & 15, cc = c & 31, ob = rr * 64 + cc * 2; return st * 1024 + (ob ^ (((ob >> 9) & 1) << 5)); }
__device__ __forceinline__ void stage_rc(int b, int& R, int& C) { const int st = b / 1024, sb = b % 1024, swz = sb ^ (((sb >> 9) & 1) << 5); R = (st >> 1) * 16 + swz / 64; C = (st & 1) * 32 + (swz % 64) / 2; }
__device__ __forceinline__ int perm32(int rho) { const int n = rho >> 4, i = rho & 15; return 8 * (i >> 2) + 4 * n + (i & 3); }
struct Unit { int pm, pn; };
struct Gemm { const bf16_t* A; const bf16_t* Bt; int M, N, K; };
struct StaticOrder {
    int nM, nN, nwg, G, c;
    __device__ void init(int M, int N, int G_, int c_) { nM = M / BM; nN = N / BM; nwg = nM * nN; G = G_; c = c_; }
    __device__ bool next(int i, Unit& u) const {
        const long L = (long)i * G + c; if (L >= nwg) return false;
        int wgid = (int)L; { const int q = nwg / NXCD, r = nwg % NXCD, xcd = wgid % NXCD, off = wgid / NXCD; wgid = (xcd < r ? xcd * (q + 1) : r * (q + 1) + (xcd - r) * q) + off; }
        const int nig = WGM * nN, gid = wgid / nig, fm = gid * WGM, gsz = (nM - fm) < WGM ? (nM - fm) : WGM;
        u.pm = fm + ((wgid % nig) % gsz); u.pn = (wgid % nig) / gsz; return true;
    }
};

template <class Epi>
__device__ __forceinline__ void gemm_phase(LAS unsigned char* lds, const Gemm g, const StaticOrder& S, const Epi& E) {
    const int tid = opaque_tid(), wid = __builtin_amdgcn_readfirstlane(tid >> 6), lane = tid & 63, wr = wid >> 2, wc = wid & 3, fr = lane & 15, fq = lane >> 4;
    const int K = g.K, nt = K / BK;
    unsigned voffA[2], voffB[2];
#pragma unroll
    for (int i = 0; i < 2; ++i) { int R, C; stage_rc(tid * 16 + i * 8192, R, C); const int Rb = Epi::PERM ? ((R & ~31) + perm32(R & 31)) : R;
        voffA[i] = (unsigned)(R * K + C) * 2u; voffB[i] = (unsigned)(Rb * K + C) * 2u; }
    const size_t kstep = (size_t)(BK * 2);
    const size_t hstep = (size_t)HALF * K * 2;
    const size_t tstep = 2 * hstep;
    const unsigned ldsw = (unsigned)wid * 1024u;
    const int aoff = lds_byte(wr * 64 + fr, fq * 8), boff = lds_byte(wc * 32 + fr, fq * 8);
#define PG8_SA(b, h) (((b) * 2 + (h)) * HTB)
#define PG8_SB(b, h) ((4 + (b) * 2 + (h)) * HTB)
#define PG8_STAGE(bufoff, gbase, voff) do { _Pragma("unroll") for (int _i = 0; _i < 2; ++_i) \
        __builtin_amdgcn_global_load_lds((const unsigned*)((const char*)(gbase) + (voff)[_i]), (LAS unsigned*)(lds + (bufoff) + ldsw + _i * 8192), 16, 0, 0); } while (0)
#define PG8_LDA(dst, b, h) do { _Pragma("unroll") for (int m = 0; m < 4; ++m) _Pragma("unroll") for (int k = 0; k < 2; ++k) dst[m][k] = *(const LAS bf16x8*)(lds + PG8_SA(b, h) + aoff + m * 2048 + k * 1024); } while (0)
#define PG8_LDB(dst, b, h) do { _Pragma("unroll") for (int n = 0; n < 2; ++n) _Pragma("unroll") for (int k = 0; k < 2; ++k) dst[n][k] = *(const LAS bf16x8*)(lds + PG8_SB(b, h) + boff + n * 2048 + k * 1024); } while (0)
#define PG8_MMA(ai, bj, At, Bt) do { __builtin_amdgcn_s_setprio(1); _Pragma("unroll") for (int m = 0; m < 4; ++m) _Pragma("unroll") for (int n = 0; n < 2; ++n) _Pragma("unroll") for (int k = 0; k < 2; ++k) \
        acc[ai][bj][m][n] = __builtin_amdgcn_mfma_f32_16x16x32_bf16(Bt[n][k], At[m][k], acc[ai][bj][m][n], 0, 0, 0); __builtin_amdgcn_s_setprio(0); } while (0)
#define PG8_WAIT_V(n) asm volatile("s_waitcnt vmcnt(" #n ")" ::: "memory")
#define PG8_WAIT_L(n) asm volatile("s_waitcnt lgkmcnt(" #n ")" ::: "memory")
#define PG8_BAR __builtin_amdgcn_s_barrier()
#define PG8_SCHED __builtin_amdgcn_sched_barrier(0)
    Unit cur, nxt; int ui = 0;
    if (!S.next(0, cur)) return;
    f32x4 acc[2][2][4][2];
#pragma unroll
    for (int a = 0; a < 2; ++a)
#pragma unroll
        for (int b = 0; b < 2; ++b)
#pragma unroll
            for (int m = 0; m < 4; ++m)
#pragma unroll
                for (int n = 0; n < 2; ++n) acc[a][b][m][n] = (f32x4){0.f, 0.f, 0.f, 0.f};
    bf16x8 At[4][2], B0[2][2], B1[2][2];
    const char* cA = (const char*)g.A + (size_t)cur.pm * tstep; const char* cB = (const char*)g.Bt + (size_t)cur.pn * tstep;
    PG8_STAGE(PG8_SB(0, 0), cB, voffB); PG8_STAGE(PG8_SA(0, 0), cA, voffA); PG8_STAGE(PG8_SB(0, 1), cB + hstep, voffB); PG8_STAGE(PG8_SA(0, 1), cA + hstep, voffA);
    if (wr == 1) PG8_BAR;
    PG8_WAIT_V(4); PG8_BAR;
    PG8_STAGE(PG8_SB(1, 0), cB + kstep, voffB); PG8_STAGE(PG8_SA(1, 0), cA + kstep, voffA); PG8_STAGE(PG8_SB(1, 1), cB + hstep + kstep, voffB);
    PG8_WAIT_V(6); PG8_BAR;
    for (;;) {
        const bool has_next = S.next(ui + 1, nxt);
        const char* nA = has_next ? (const char*)g.A + (size_t)nxt.pm * tstep : cA; const char* nB = has_next ? (const char*)g.Bt + (size_t)nxt.pn * tstep : cB;
        for (int t = 0; t < nt; t += 2) {
            const bool last = (t == nt - 2);
            const char* a1 = cA + (size_t)(t + 1) * kstep;
            const char* a2 = last ? nA : cA + (size_t)(t + 2) * kstep; const char* b2 = last ? nB : cB + (size_t)(t + 2) * kstep;
            const char* a3 = a2 + kstep; const char* b3 = b2 + kstep;
            PG8_LDB(B0, 0, 0); PG8_SCHED; PG8_LDA(At, 0, 0); PG8_STAGE(PG8_SA(1, 1), a1 + hstep, voffA);
            PG8_WAIT_L(8); PG8_BAR; PG8_WAIT_L(0); PG8_MMA(0, 0, At, B0); PG8_BAR; PG8_SCHED;
            PG8_LDB(B1, 0, 1); PG8_STAGE(PG8_SB(0, 0), b2, voffB);
            PG8_BAR; PG8_WAIT_L(0); PG8_MMA(0, 1, At, B1); PG8_BAR;
            PG8_LDA(At, 0, 1); PG8_STAGE(PG8_SA(0, 0), a2, voffA);
            PG8_BAR; PG8_WAIT_L(0); PG8_MMA(1, 0, At, B0); PG8_BAR; PG8_SCHED;
            PG8_STAGE(PG8_SB(0, 1), b2 + hstep, voffB);
            PG8_WAIT_V(6); PG8_BAR; PG8_MMA(1, 1, At, B1); PG8_BAR;
            PG8_LDB(B0, 1, 0); PG8_SCHED; PG8_LDA(At, 1, 0); PG8_STAGE(PG8_SA(0, 1), a2 + hstep, voffA);
            PG8_WAIT_L(8); PG8_BAR; PG8_WAIT_L(0); PG8_MMA(0, 0, At, B0); PG8_BAR; PG8_SCHED;
            PG8_LDB(B1, 1, 1); PG8_STAGE(PG8_SB(1, 0), b3, voffB);
            PG8_BAR; PG8_WAIT_L(0); PG8_MMA(0, 1, At, B1); PG8_BAR;
            PG8_LDA(At, 1, 1); PG8_STAGE(PG8_SA(1, 0), a3, voffA);
            PG8_BAR; PG8_WAIT_L(0); PG8_MMA(1, 0, At, B0); PG8_BAR; PG8_SCHED;
            PG8_STAGE(PG8_SB(1, 1), b3 + hstep, voffB);
            PG8_WAIT_V(6); PG8_BAR; PG8_MMA(1, 1, At, B1); PG8_BAR;
        }
        E(acc, cur, wr, wc, fr, fq);
        if (!has_next) break;
#pragma unroll
        for (int a = 0; a < 2; ++a)
#pragma unroll
            for (int b = 0; b < 2; ++b)
#pragma unroll
                for (int m = 0; m < 4; ++m)
#pragma unroll
                    for (int n = 0; n < 2; ++n) acc[a][b][m][n] = (f32x4){0.f, 0.f, 0.f, 0.f};
        cur = nxt; cA = nA; cB = nB; ++ui;
    }
    PG8_WAIT_V(0);
    if (wr == 0) PG8_BAR;
    PG8_BAR;
#undef PG8_SA
#undef PG8_SB
#undef PG8_STAGE
#undef PG8_LDA
#undef PG8_LDB
#undef PG8_MMA
#undef PG8_WAIT_V
#undef PG8_WAIT_L
#undef PG8_BAR
#undef PG8_SCHED
}
}

enum { EM_PLAIN = 0, EM_Z, EM_LORA, EM_POOLW, EM_VUP, EM_MERGE };
struct Epi {
    static constexpr bool PERM = true;
    int mode, ldo, sub, accum;
    bf16_t* O;
    const float* b0; const float* b1;
    const bf16_t* X0;
    __device__ __forceinline__ void operator()(const f32x4 (&acc)[2][2][4][2], const pg8::Unit& u, int wr, int wc, int fr, int fq) const {
        const int pn = u.pn;
        int act = 0, ld = ldo, cb = pn * 256; bf16_t* base = O; const float* bias = nullptr;
        if (mode == EM_Z) {
            if (pn < 2) { ld = 512; cb = pn * 256; }
            else if (pn < 4) { base = O + (WS_ZQ - WS_ZP) / 2; ld = 512; cb = (pn - 2) * 256; }
            else if (pn < 16) { base = O + (WS_ZR - WS_ZP) / 2 + (size_t)((pn - 4) >> 2) * TH * 1024; ld = 1024; cb = ((pn - 4) & 3) * 256; }
            else if (pn == 16) { base = O + (WS_ZL - WS_ZP) / 2; ld = 256; cb = 0; }
            else { base = O + (WS_GATES - WS_ZP) / 2; ld = 3072; cb = (pn - 17) * 256; act = 1; bias = b0 + cb; }
        } else if (mode == EM_LORA) {
            const int seg = pn >> 2; base = O + (size_t)seg * TH * 1024; ld = 1024; cb = (pn & 3) * 256;
            act = seg == 0 ? 3 : (seg == 1 ? 2 : 0); bias = seg == 0 ? b0 + cb : b1 + cb;
        } else if (mode == EM_POOLW) { act = 4; }
        const int row0 = u.pm * 256 + wr * 64 + fr;
        const int cw = wc * 32 + 8 * fq;
#pragma unroll
        for (int ai = 0; ai < 2; ++ai)
#pragma unroll
            for (int m = 0; m < 4; ++m) {
                const size_t row = (size_t)(row0 + ai * 128 + m * 16);
#pragma unroll
                for (int bj = 0; bj < 2; ++bj) {
                    const int cl = bj * 128 + cw;
                    const int colg = pn * 256 + cl;
                    float v[8];
#pragma unroll
                    for (int e = 0; e < 4; ++e) { v[e] = acc[ai][bj][m][0][e]; v[4 + e] = acc[ai][bj][m][1][e]; }
                    if (mode == EM_MERGE) {
                        float gt[8]; unpack8(*(const u32x4*)(X0 + row * 3072 + sub * 1024 + colg), gt);
                        bf16_t* op = O + row * 1024 + colg;
                        if (!accum) {
#pragma unroll
                            for (int e = 0; e < 8; ++e) v[e] *= gt[e];
                        } else {
                            float old[8]; unpack8(*(const u32x4*)op, old);
#pragma unroll
                            for (int e = 0; e < 8; ++e) v[e] = old[e] + gt[e] * v[e];
                        }
                        *(u32x4*)op = pack8(v);
                    } else if (mode == EM_VUP) {
                        bf16_t* op = O + row * 1024 + colg;
                        float vl[8], vf[8]; unpack8(*(const u32x4*)op, vl); unpack8(*(const u32x4*)(X0 + row * 1024 + colg), vf);
                        const f32x4 c0 = *(const f32x4*)(b0 + colg), c1 = *(const f32x4*)(b0 + colg + 4);
#pragma unroll
                        for (int e = 0; e < 8; ++e) { const float bb = e < 4 ? c0[e & 3] : c1[e & 3]; v[e] = vl[e] + (vf[e] - vl[e]) * sigmoidf_(bb + v[e]); }
                        *(u32x4*)op = pack8(v);
                    } else {
                        bf16_t* op = base + row * ld + cb + cl;
                        if (act == 4) {
                            const f32x4 c0 = *(const f32x4*)(b0 + colg), c1 = *(const f32x4*)(b0 + colg + 4), s0 = *(const f32x4*)(b1 + colg), s1 = *(const f32x4*)(b1 + colg + 4);
#pragma unroll
                            for (int e = 0; e < 8; ++e) v[e] = (v[e] + (e < 4 ? c0[e & 3] : c1[e & 3])) * (e < 4 ? s0[e & 3] : s1[e & 3]);
                            *(u32x4*)op = pack8(v);
                        } else if (act == 0) {
                            *(u32x4*)op = pack8(v);
                        } else {
                            const f32x4 c0 = *(const f32x4*)(bias + cl), c1 = *(const f32x4*)(bias + cl + 4);
#pragma unroll
                            for (int e = 0; e < 8; ++e) v[e] = sigmoidf_(v[e] + (e < 4 ? c0[e & 3] : c1[e & 3]));
                            if (act == 1) *(u32x4*)op = pack8(v);
                            else {
                                if (act == 3) {
#pragma unroll
                                    for (int e = 0; e < 8; ++e) v[e] = 1.0f - __expf(-0.6065306597f * v[e]);
                                }
                                u32x4 w; w.x = pk_h2(v[0], v[1]); w.y = pk_h2(v[2], v[3]); w.z = pk_h2(v[4], v[5]); w.w = pk_h2(v[6], v[7]);
                                *(u32x4*)op = w;
                            }
                        }
                    }
                }
            }
    }
};

__device__ __forceinline__ void run_gemm(LAS unsigned char* lds, const bf16_t* A, const bf16_t* Bt, int M, int N, int K, const Epi& E) {
    pg8::Gemm g; g.A = A; g.Bt = Bt; g.M = M; g.N = N; g.K = K;
    pg8::StaticOrder S; S.init(M, N, (int)gridDim.x, (int)blockIdx.x);
    pg8::gemm_phase<Epi>(lds, g, S, E);
}
__device__ __forceinline__ void run_gemm_on(LAS unsigned char* lds, const bf16_t* A, const bf16_t* Bt, int M, int N, int K, const Epi& E, int first, int count) {
    const int b = (int)blockIdx.x - first;
    if (b < 0 || b >= count) return;
    pg8::Gemm g; g.A = A; g.Bt = Bt; g.M = M; g.N = N; g.K = K;
    pg8::StaticOrder S; S.init(M, N, count, b);
    pg8::gemm_phase<Epi>(lds, g, S, E);
}
__device__ __forceinline__ Epi mk_epi(int mode, bf16_t* O, int ldo, const float* b0 = nullptr, const float* b1 = nullptr, const bf16_t* X0 = nullptr, int sub = 0, int accum = 0) {
    Epi e; e.mode = mode; e.ldo = ldo; e.sub = sub; e.accum = accum; e.O = O; e.b0 = b0; e.b1 = b1; e.X0 = X0; return e;
}

__device__ __forceinline__ void cvt_job(LAS float* tile, int& rot, bf16_t* dst, int dstLd, int nrows, const float* src, int srcLd, int srcK, int srcN, int k0) {
    const int tid = opaque_tid(), G = gridDim.x;
    const int tk = dstLd / 256, tn = nrows / 64, ntiles = tk * tn;
    for (int t = (int)((blockIdx.x + G - (rot % G)) % G); t < ntiles; t += G) {
        const int tn0 = (t / tk) * 64, tk0 = (t % tk) * 256;
        {
            const int kk = tid >> 4, n4 = (tid & 15) * 4, n = tn0 + n4;
            f32x4 v[8];
#pragma unroll
            for (int p = 0; p < 8; ++p) {
                const int ks = tk0 + kk + p * 32 - k0;
                v[p] = (f32x4){0.f, 0.f, 0.f, 0.f};
                if (ks >= 0 && ks < srcK && n < srcN) v[p] = *(const f32x4*)(src + (size_t)ks * srcLd + n);
            }
#pragma unroll
            for (int p = 0; p < 8; ++p) { const int kl = kk + p * 32; tile[kl * 65 + n4 + 0] = v[p][0]; tile[kl * 65 + n4 + 1] = v[p][1]; tile[kl * 65 + n4 + 2] = v[p][2]; tile[kl * 65 + n4 + 3] = v[p][3]; }
        }
        __syncthreads();
        {
            const int n = tid >> 3;
#pragma unroll
            for (int p = 0; p < 4; ++p) {
                const int k8 = (tid & 7) * 8 + p * 64;
                float v[8];
#pragma unroll
                for (int e = 0; e < 8; ++e) v[e] = tile[(k8 + e) * 65 + n];
                *(u32x4*)(dst + (size_t)(tn0 + n) * dstLd + tk0 + k8) = pack8(v);
            }
        }
        __syncthreads();
    }
    rot += ntiles;
}

__device__ __forceinline__ void cvt_mixer(LAS unsigned char* lds, const Params& p, int l) {
    LAS float* tile = (LAS float*)lds; int rot = 0; size_t wo = WS_W; asm volatile("" : "+s"(wo)); unsigned char* W = p.ws + wo;
    cvt_job(tile, rot, (bf16_t*)(W + W_IN), 1024, INC, p.w_in + (size_t)l * 1024 * INC, INC, 1024, INC, 0);
    for (int g = 0; g < 4; ++g) cvt_job(tile, rot, (bf16_t*)(W + W_POOL) + (size_t)g * 128 * 512, 512, 128, p.pool_w + ((size_t)l * 4 + g) * 128 * 128, 128, 128, 128, g * 128);
    cvt_job(tile, rot, (bf16_t*)(W + W_PP), 512, 1024, p.w_proj_pool + (size_t)l * 512 * 1024, 1024, 512, 1024, 0);
    cvt_job(tile, rot, (bf16_t*)(W + W_K), 1024, 512, p.w_mem_kv + (size_t)l * 1024 * 1024, 1024, 1024, 512, 0);
    cvt_job(tile, rot, (bf16_t*)(W + W_V), 1024, 512, p.w_mem_kv + (size_t)l * 1024 * 1024 + 512, 1024, 1024, 512, 0);
    cvt_job(tile, rot, (bf16_t*)(W + W_PM), 512, 1024, p.w_proj_mem + (size_t)l * 512 * 1024, 1024, 512, 1024, 0);
    cvt_job(tile, rot, (bf16_t*)(W + W_LORA), 256, 1024, p.w_up_decay + (size_t)l * 64 * 1024, 1024, 64, 1024, 0);
    cvt_job(tile, rot, (bf16_t*)(W + W_LORA) + (size_t)1024 * 256, 256, 1024, p.w_up_a + (size_t)l * 64 * 1024, 1024, 64, 1024, 64);
    cvt_job(tile, rot, (bf16_t*)(W + W_LORA) + (size_t)2048 * 256, 256, 1024, p.w_up_g + (size_t)l * 128 * 1024, 1024, 128, 1024, 128);
    if (l > 0) {
        cvt_job(tile, rot, (bf16_t*)(W + W_DOWN), 1024, 256, p.w_down_v + (size_t)(l - 1) * 1024 * 32, 32, 1024, 32, 0);
        cvt_job(tile, rot, (bf16_t*)(W + W_UP), 256, 1024, p.w_up_v + (size_t)(l - 1) * 32 * 1024, 1024, 32, 1024, 0);
    }
    cvt_job(tile, rot, (bf16_t*)(W + W_PR), 1024, 1024, p.w_proj_rwkv + (size_t)l * 1024 * 1024, 1024, 1024, 1024, 0);
    cvt_job(tile, rot, (bf16_t*)(W + W_O), 1024, 1024, p.w_o + (size_t)l * 1024 * 1024, 1024, 1024, 1024, 0);
}
__device__ __forceinline__ void cvt_ffn(LAS unsigned char* lds, const Params& p, int l) {
    LAS float* tile = (LAS float*)lds; int rot = 0; size_t wo = WS_W; asm volatile("" : "+s"(wo)); unsigned char* W = p.ws + wo;
    cvt_job(tile, rot, (bf16_t*)(W + W_FU), 1024, 2 * DFF, p.w_ffn_up + (size_t)l * 1024 * 2 * DFF, 2 * DFF, 1024, 2 * DFF, 0);
    cvt_job(tile, rot, (bf16_t*)(W + W_FD), DFF, 1024, p.w_ffn_down + (size_t)l * DFF * 1024, 1024, DFF, 1024, 0);
}

__device__ __forceinline__ void row_phase(const float* xin, const bf16_t* y, const float* gpost, float* xout, const float* gpre, bf16_t* hout, int rows, const bf16_t* y2 = nullptr) {
    const int tid_ = opaque_tid(); const int wid = tid_ >> 6, lane = tid_ & 63;
    f32x4 gq[4], gp[4];
#pragma unroll
    for (int i = 0; i < 4; ++i) { gq[i] = gpost ? *(const f32x4*)(gpost + i * 256 + lane * 4) : (f32x4){0.f, 0.f, 0.f, 0.f}; gp[i] = gpre ? *(const f32x4*)(gpre + i * 256 + lane * 4) : (f32x4){0.f, 0.f, 0.f, 0.f}; }
    for (int r = blockIdx.x * 8 + wid; r < rows; r += gridDim.x * 8) {
        f32x4 x[4];
#pragma unroll
        for (int i = 0; i < 4; ++i) x[i] = *(const f32x4*)(xin + (size_t)r * D + i * 256 + lane * 4);
        if (y) {
            float yv[4][4]; float ss = 0.f;
#pragma unroll
            for (int i = 0; i < 4; ++i) { const u32x2 w = *(const u32x2*)(y + (size_t)r * D + i * 256 + lane * 4);
                yv[i][0] = bf_lo(w.x); yv[i][1] = bf_hi(w.x); yv[i][2] = bf_lo(w.y); yv[i][3] = bf_hi(w.y);
                if (y2) { const u32x2 w2 = *(const u32x2*)(y2 + (size_t)r * D + i * 256 + lane * 4); yv[i][0] += bf_lo(w2.x); yv[i][1] += bf_hi(w2.x); yv[i][2] += bf_lo(w2.y); yv[i][3] += bf_hi(w2.y); }
#pragma unroll
                for (int e = 0; e < 4; ++e) ss += yv[i][e] * yv[i][e]; }
            ss = wave_sum_dpp(ss);
            const float rs = rsqrtf(ss * (1.0f / D) + 1e-6f);
#pragma unroll
            for (int i = 0; i < 4; ++i) { const f32x4 g = gq[i];
#pragma unroll
                for (int e = 0; e < 4; ++e) x[i][e] += yv[i][e] * rs * g[e];
                *(f32x4*)(xout + (size_t)r * D + i * 256 + lane * 4) = x[i]; }
        }
        if (hout) {
            float ss = 0.f;
#pragma unroll
            for (int i = 0; i < 4; ++i)
#pragma unroll
                for (int e = 0; e < 4; ++e) ss += x[i][e] * x[i][e];
            ss = wave_sum_dpp(ss);
            const float rs = rsqrtf(ss * (1.0f / D) + 1e-6f);
#pragma unroll
            for (int i = 0; i < 4; ++i) { const f32x4 g = gp[i];
                u32x2 w; w.x = cvt_pk_bf16(x[i][0] * rs * g[0], x[i][1] * rs * g[1]); w.y = cvt_pk_bf16(x[i][2] * rs * g[2], x[i][3] * rs * g[3]);
                *(u32x2*)(hout + (size_t)r * D + i * 256 + lane * 4) = w; }
        }
    }
}

__device__ __forceinline__ void pool_phase(const bf16_t* zp, bf16_t* pooled) {
    const size_t total = (size_t)TH * 64, stride = (size_t)gridDim.x * 512;
    for (size_t i = (size_t)blockIdx.x * 512 + opaque_tid(); i < total; i += stride) {
        const int tok = (int)(i >> 6), c8 = (int)(i & 63), t = tok & (SEQ - 1);
        const int win = 2 << (c8 >> 4); const int n = (t + 1) < win ? (t + 1) : win;
        float s[8], self[8];
        unpack8(*(const u32x4*)(zp + (size_t)tok * 512 + c8 * 8), self);
#pragma unroll
        for (int e = 0; e < 8; ++e) s[e] = self[e];
        for (int j = 1; j < n; ++j) { float v[8]; unpack8(*(const u32x4*)(zp + (size_t)(tok - j) * 512 + c8 * 8), v);
#pragma unroll
            for (int e = 0; e < 8; ++e) s[e] += v[e]; }
        const float inv = 1.0f / (float)n;
#pragma unroll
        for (int e = 0; e < 8; ++e) s[e] = s[e] * inv - self[e];
        *(u32x4*)(pooled + (size_t)tok * 512 + c8 * 8) = pack8(s);
    }
}

__device__ __forceinline__ void prep_phase(const bf16_t* zrkv  , const bf16_t* zl, const float* mu, bf16_t* rl, bf16_t* kl, bf16_t* vl, bf16_t* Al, const float* k_k, float* kinv) {
    constexpr int STRIP = 32;
    const int items = 416 * (TH / STRIP), stride = (int)gridDim.x * 512;
    for (int it = (int)blockIdx.x * 512 + opaque_tid(); it < items; it += stride) {
        const int ci = it % 416, strip = it / 416, c = ci * 8, tok0 = strip * STRIP, t0 = tok0 & (SEQ - 1);
        const bf16_t* src; bf16_t* dst; int ld;
        if (c < 3072) { const int arr = c >> 10, cc = c & 1023; src = zrkv + (size_t)arr * TH * 1024 + cc; ld = 1024; dst = (arr == 0 ? rl : (arr == 1 ? kl : vl)) + cc; }
        else { src = zl + (c - 3072); ld = 256; dst = Al + (c - 3072); }
        const bool isk = c >= 1024 && c < 2048; const int cc = isk ? c - 1024 : 0, cl = c - 3072;
        float m[8], kq[8];
        { const f32x4 m0 = *(const f32x4*)(mu + c), m1 = *(const f32x4*)(mu + c + 4), q0 = *(const f32x4*)(k_k + cc), q1 = *(const f32x4*)(k_k + cc + 4);
#pragma unroll
          for (int e = 0; e < 4; ++e) { m[e] = m0[e]; m[4 + e] = m1[e]; kq[e] = q0[e]; kq[4 + e] = q1[e]; } }
        float zp[8];
        if (t0 > 0) unpack8(*(const u32x4*)(src + (size_t)(tok0 - 1) * ld), zp);
        else {
#pragma unroll
            for (int e = 0; e < 8; ++e) zp[e] = 0.f;
        }
#pragma unroll 4
        for (int i = 0; i < STRIP; ++i) {
            const size_t tok = (size_t)(tok0 + i);
            float z[8], o[8];
            unpack8(*(const u32x4*)(src + tok * ld), z);
            float ss = 0.f;
#pragma unroll
            for (int e = 0; e < 8; ++e) { o[e] = z[e] + (zp[e] - z[e]) * m[e]; zp[e] = z[e]; const float kk = o[e] * kq[e]; ss += kk * kk; }
            ss = sum8(ss);
            if (isk && (ci & 7) == 0) kinv[tok * 16 + (cc >> 6)] = rsqrtf(ss + 1e-12f);
            if (cl >= 0) {
                if (cl < 64) {
#pragma unroll
                    for (int e = 0; e < 8; ++e) o[e] = tanhf_(o[e]);
                } else if (cl >= 128) {
#pragma unroll
                    for (int e = 0; e < 8; ++e) o[e] = sigmoidf_(o[e]);
                }
            }
            *(u32x4*)(dst + tok * ld) = pack8(o);
        }
    }
}

__device__ __forceinline__ void attn_phase(LAS unsigned char* lds, bf16_t* zq, const bf16_t* Kmem, const bf16_t* Vt, int half) {
    LAS bf16_t* Ks = (LAS bf16_t*)lds;
    LAS bf16_t* Vs = (LAS bf16_t*)(lds + 256 * 136 * 2);
    const int tid = opaque_tid(), wid = tid >> 6, lane = tid & 63, fr = lane & 15, fq = lane >> 4;
    for (int it0 = blockIdx.x; it0 < 256; it0 += gridDim.x) {
        const int item = ((it0 & 7) << 5) | (it0 >> 3);
        const int bl = item >> 6, h = (item >> 4) & 3, qt = item & 15, gb = half * 4 + bl;
#pragma unroll
        for (int i = 0; i < 8; ++i) { const int ch = tid + i * 512, m = ch >> 4, d8 = (ch & 15) * 8;
            *(LAS u32x4*)(Ks + m * 136 + d8) = *(const u32x4*)(Kmem + (size_t)(gb * 256 + m) * 512 + h * 128 + d8); }
#pragma unroll
        for (int i = 0; i < 8; ++i) { const int ch = tid + i * 512, d = ch >> 5, m8 = (ch & 31) * 8;
            *(LAS u32x4*)(Vs + d * 264 + m8) = *(const u32x4*)(Vt + (size_t)(h * 128 + d) * 2048 + gb * 256 + m8); }
        __syncthreads();
        const size_t tok = (size_t)bl * SEQ + qt * 128 + wid * 16 + fr;
        bf16_t* qp = zq + tok * 512 + h * 128;
        bf16x8 q[4];
#pragma unroll
        for (int ks = 0; ks < 4; ++ks) q[ks] = *(const bf16x8*)(qp + ks * 32 + fq * 8);
        f32x4 sacc[16];
#pragma unroll
        for (int n = 0; n < 16; ++n) sacc[n] = (f32x4){0.f, 0.f, 0.f, 0.f};
#pragma unroll
        for (int n = 0; n < 16; ++n)
#pragma unroll
            for (int ks = 0; ks < 4; ++ks) { const bf16x8 kf = *(const LAS bf16x8*)(Ks + (16 * n + fr) * 136 + ks * 32 + fq * 8);
                sacc[n] = __builtin_amdgcn_mfma_f32_16x16x32_bf16(kf, q[ks], sacc[n], 0, 0, 0); }
        float mx = -3.0e38f;
#pragma unroll
        for (int n = 0; n < 16; ++n)
#pragma unroll
            for (int e = 0; e < 4; ++e) mx = fmaxf(mx, sacc[n][e]);
        mx = fmaxf(mx, __shfl_xor(mx, 16)); mx = fmaxf(mx, __shfl_xor(mx, 32));
        const float sc = 0.08838834764831845f;
        float sum = 0.f;
#pragma unroll
        for (int n = 0; n < 16; ++n)
#pragma unroll
            for (int e = 0; e < 4; ++e) { const float pz = __expf((sacc[n][e] - mx) * sc); sacc[n][e] = pz; sum += pz; }
        sum += __shfl_xor(sum, 16); sum += __shfl_xor(sum, 32);
        f32x4 oacc[8];
#pragma unroll
        for (int n = 0; n < 8; ++n) oacc[n] = (f32x4){0.f, 0.f, 0.f, 0.f};
#pragma unroll
        for (int kk = 0; kk < 8; ++kk) {
            u32x4 pw; pw.x = cvt_pk_bf16(sacc[2 * kk][0], sacc[2 * kk][1]); pw.y = cvt_pk_bf16(sacc[2 * kk][2], sacc[2 * kk][3]);
            pw.z = cvt_pk_bf16(sacc[2 * kk + 1][0], sacc[2 * kk + 1][1]); pw.w = cvt_pk_bf16(sacc[2 * kk + 1][2], sacc[2 * kk + 1][3]);
            const bf16x8 pf = __builtin_bit_cast(bf16x8, pw);
#pragma unroll
            for (int n = 0; n < 8; ++n) {
                const u32x2 v0 = *(const LAS u32x2*)(Vs + (16 * n + fr) * 264 + 32 * kk + 4 * fq), v1 = *(const LAS u32x2*)(Vs + (16 * n + fr) * 264 + 32 * kk + 16 + 4 * fq);
                u32x4 vw; vw.x = v0.x; vw.y = v0.y; vw.z = v1.x; vw.w = v1.y;
                oacc[n] = __builtin_amdgcn_mfma_f32_16x16x32_bf16(__builtin_bit_cast(bf16x8, vw), pf, oacc[n], 0, 0, 0);
            }
        }
        const float inv = 1.0f / sum;
#pragma unroll
        for (int n = 0; n < 8; ++n) { u32x2 w; w.x = cvt_pk_bf16(oacc[n][0] * inv, oacc[n][1] * inv); w.y = cvt_pk_bf16(oacc[n][2] * inv, oacc[n][3] * inv);
            *(u32x2*)(qp + 16 * n + 4 * fq) = w; }
        __syncthreads();
    }
}

struct ScanRaw { u32x2 r, k, v, om, a; float inv; };
typedef float f32x2 __attribute__((ext_vector_type(2)));
__device__ __forceinline__ void scan_bar() { asm volatile("s_waitcnt lgkmcnt(0)\n\ts_barrier" ::: "memory"); }
__device__ __forceinline__ void unpack4(const u32x2 w, float (&v)[4]) { v[0] = bf_lo(w.x); v[1] = bf_hi(w.x); v[2] = bf_lo(w.y); v[3] = bf_hi(w.y); }
__device__ __forceinline__ void unpack4h(const u32x2 w, float (&v)[4]) {
    typedef _Float16 h2 __attribute__((ext_vector_type(2)));
    const unsigned w0 = w.x, w1 = w.y; const h2 a = __builtin_bit_cast(h2, w0), b = __builtin_bit_cast(h2, w1);
    v[0] = (float)a.x; v[1] = (float)a.y; v[2] = (float)b.x; v[3] = (float)b.y;
}
__device__ __forceinline__ void scan_phase(LAS unsigned char* lds, const bf16_t* rl, const bf16_t* kl, const bf16_t* vl, const bf16_t* omw, const bf16_t* aa, const float* kinv, bf16_t* y, const float* k_k, const float* k_a) {
    constexpr int CH = 32, REC = 320, NC = SEQ / CH, YB = (CH / 4) * 16 * 17 * 4;
    LAS float* bufs = (LAS float*)lds;
    LAS float* yp = (LAS float*)(lds + 2 * CH * REC * 4);
    LAS float* vb = yp + 2 * YB;
    const int tid = opaque_tid();
    const bool loader = tid >= 256;
    for (int it0 = blockIdx.x; it0 < 256; it0 += gridDim.x) {
        const int item = ((it0 & 7) << 5) | (it0 >> 3);
        const int bh = item >> 2, rg = item & 3, bl = bh >> 4, head = bh & 15;
        const size_t tok0 = (size_t)bl * SEQ; const int ch0 = head * 64;
        const int lt = tid & 255, ls = lt >> 4, cg4 = lt & 15, lc = ch0 + cg4 * 4;
        const int ys = lt >> 4, yrow = lt & 15;
        float kkc[4], kac[4];
#pragma unroll
        for (int e = 0; e < 4; ++e) { kkc[e] = k_k[lc + e]; kac[e] = k_a[lc + e]; }
        auto load_raw = [&](int chunk, int sub) { ScanRaw raw; const size_t tk = tok0 + (size_t)chunk * CH + ls + 16 * sub, idx = tk * 1024 + lc;
            raw.r = *(const u32x2*)(rl + idx); raw.k = *(const u32x2*)(kl + idx); raw.v = *(const u32x2*)(vl + idx); raw.om = *(const u32x2*)(omw + idx); raw.a = *(const u32x2*)(aa + idx);
            raw.inv = kinv[tk * 16 + head]; return raw; };
        ScanRaw rw0, rw1, rw2, rx0, rx1, rx2;
        auto prep_store = [&](LAS float* b, LAS float* vbuf, const ScanRaw& raw, int sub) {
            const int ls = (lt >> 4) + 16 * sub;
            float r[4], k[4], v[4], om[4], a[4];
            unpack4(raw.r, r); unpack4(raw.k, k); unpack4(raw.v, v); unpack4h(raw.om, om); unpack4h(raw.a, a);
            f32x4 an, w, bn, ke, rr, vv;
#pragma unroll
            for (int e = 0; e < 4; ++e) { const float kk = k[e] * (kkc[e] * raw.inv); an[e] = -kk; w[e] = 1.0f - om[e]; bn[e] = kk * a[e]; ke[e] = k[e] * (1.0f + (a[e] - 1.0f) * kac[e]); rr[e] = r[e]; vv[e] = v[e]; }
            LAS float* rec = b + ls * REC + cg4 * 4;
            *(LAS f32x4*)(rec) = an; *(LAS f32x4*)(rec + 64) = w; *(LAS f32x4*)(rec + 128) = bn; *(LAS f32x4*)(rec + 192) = ke; *(LAS f32x4*)(rec + 256) = rr;
            if ((cg4 >> 2) == rg) { LAS float* vd = vbuf + ((cg4 & 3) * 4) * CH + ls; vd[0] = vv[0]; vd[CH] = vv[1]; vd[2 * CH] = vv[2]; vd[3 * CH] = vv[3]; }
        };
        auto write_y = [&](int chunk) {
            if (lt < 16 * (CH / 4)) {
                const int g4 = lt >> 4, yrow4 = lt & 15;
                const LAS float* pp = yp + (chunk & 1) * YB + (g4 * 16 + yrow4) * 17 * 4;
                f32x4 t4 = *(const LAS f32x4*)(pp);
#pragma unroll
                for (int i = 1; i < 16; ++i) t4 += *(const LAS f32x4*)(pp + 4 * i);
                bf16_t* yd = y + (tok0 + (size_t)chunk * CH + 4 * g4) * 1024 + ch0 + rg * 16 + yrow4;
#pragma unroll
                for (int j = 0; j < 4; ++j) yd[(size_t)j * 1024] = (bf16_t)(cvt_pk_bf16(t4[j], 0.f) & 0xffffu);
            } };
        const int l = tid & 63, rloc = ((tid >> 6) & 3) * 4 + (l >> 4), c4 = (l & 15) * 4;
        f32x2 S01 = (f32x2){0.f, 0.f}, S23 = (f32x2){0.f, 0.f};

        if (loader) { rw0 = load_raw(0, 0); rx0 = load_raw(0, 1); prep_store(bufs, vb, rw0, 0); prep_store(bufs, vb, rx0, 1);
            rw0 = load_raw(1, 0); rx0 = load_raw(1, 1); rw1 = load_raw(2, 0); rx1 = load_raw(2, 1); rw2 = load_raw(3, 0); rx2 = load_raw(3, 1); }
        scan_bar();
        for (int c = 0; c < NC; ++c) {
            if (loader) {
                if (c + 1 < NC) { prep_store(bufs + ((c + 1) & 1) * (CH * REC), vb + ((c + 1) & 1) * (16 * CH), rw0, 0); prep_store(bufs + ((c + 1) & 1) * (CH * REC), vb + ((c + 1) & 1) * (16 * CH), rx0, 1); }
                rw0 = rw1; rw1 = rw2; rx0 = rx1; rx1 = rx2;
                if (c + 4 < NC) { rw2 = load_raw(c + 4, 0); rx2 = load_raw(c + 4, 1); }
                if (c >= 1) write_y(c - 1);
            } else {
                if ((tid >> 7) & 1) __builtin_amdgcn_s_sleep(1);
                LAS float* b = bufs + (c & 1) * (CH * REC);
                LAS float* yo = yp + (c & 1) * YB + (rloc * 17 + (l & 15)) * 4;
                f32x4 an = *(LAS f32x4*)(b + c4), w = *(LAS f32x4*)(b + 64 + c4), bn = *(LAS f32x4*)(b + 128 + c4), kx = *(LAS f32x4*)(b + 192 + c4), rr = *(LAS f32x4*)(b + 256 + c4);
                f32x4 v4[CH / 4];
#pragma unroll
                for (int g = 0; g < CH / 4; ++g) v4[g] = *(LAS f32x4*)(vb + (c & 1) * (16 * CH) + rloc * CH + 4 * g);
                f32x4 yq;
#pragma unroll
                for (int s = 0; s < CH; ++s) {
                    const f32x4 an_ = an, w_ = w, bn_ = bn, k_ = kx, r_ = rr; const float v_ = v4[s >> 2][s & 3];
                    if (s + 1 < CH) { LAS float* nb = b + (s + 1) * REC;
                        an = *(LAS f32x4*)(nb + c4); w = *(LAS f32x4*)(nb + 64 + c4); bn = *(LAS f32x4*)(nb + 128 + c4); kx = *(LAS f32x4*)(nb + 192 + c4); rr = *(LAS f32x4*)(nb + 256 + c4); }
                    f32x2 p2 = S01 * (f32x2){an_[0], an_[1]}; p2 = S23 * (f32x2){an_[2], an_[3]} + p2;
                    float sa = p2[0] + p2[1];
                    const f32x2 vv2 = (f32x2){v_, v_};
                    const f32x2 t01 = S01 * (f32x2){w_[0], w_[1]} + (f32x2){k_[0], k_[1]} * vv2, t23 = S23 * (f32x2){w_[2], w_[3]} + (f32x2){k_[2], k_[3]} * vv2;
                    sa = row16_sum(sa);
                    const f32x2 sa2 = (f32x2){sa, sa};
                    S01 = (f32x2){bn_[0], bn_[1]} * sa2 + t01; S23 = (f32x2){bn_[2], bn_[3]} * sa2 + t23;
                    f32x2 q2 = S01 * (f32x2){r_[0], r_[1]}; q2 = S23 * (f32x2){r_[2], r_[3]} + q2;
                    yq[s & 3] = q2[0] + q2[1];
                    if ((s & 3) == 3) *(LAS f32x4*)(yo + (s >> 2) * (16 * 17 * 4)) = yq;
                }
            }
            scan_bar();
        }
        if (loader) write_y(NC - 1);
        scan_bar();
    }
}

__device__ __forceinline__ void post_phase(bf16_t* y, const bf16_t* rl, const bf16_t* kl, const bf16_t* vl, const bf16_t* aa, const bf16_t* gg, const float* k_a, const float* r_k, const float* lnw, const float* lnb) {
    constexpr int STRIP = 8;
    const int items = 128 * (TH / STRIP), stride = (int)gridDim.x * 512;
    for (int it = (int)blockIdx.x * 512 + opaque_tid(); it < items; it += stride) {
        int c = (it & 127) * 8; size_t tok0 = (size_t)(it >> 7) * STRIP;
        if (gridDim.x == 256) {
            const int x = (int)blockIdx.x & 7, g = ((int)blockIdx.x >> 3) * 512 + (it & 511);
            c = (x & 1) * 512 + (g & 63) * 8; tok0 = (size_t)(x >> 1) * SEQ + (size_t)(g >> 6) * STRIP;
        }
        float ka[8], rk[8], lw[8], lb[8];
        { const f32x4 a0 = *(const f32x4*)(k_a + c), a1 = *(const f32x4*)(k_a + c + 4), b0 = *(const f32x4*)(r_k + c), b1 = *(const f32x4*)(r_k + c + 4),
                      c0 = *(const f32x4*)(lnw + c), c1 = *(const f32x4*)(lnw + c + 4), d0 = *(const f32x4*)(lnb + c), d1 = *(const f32x4*)(lnb + c + 4);
#pragma unroll
          for (int e = 0; e < 4; ++e) { ka[e] = a0[e]; ka[4 + e] = a1[e]; rk[e] = b0[e]; rk[4 + e] = b1[e]; lw[e] = c0[e]; lw[4 + e] = c1[e]; lb[e] = d0[e]; lb[4 + e] = d1[e]; } }
#pragma unroll 2
        for (int i = 0; i < STRIP; ++i) {
            const size_t idx = (tok0 + i) * 1024 + c;
            float yv[8], r[8], k[8], v[8], a[8], g[8];
            unpack8(*(const u32x4*)(y + idx), yv); unpack8(*(const u32x4*)(rl + idx), r); unpack8(*(const u32x4*)(kl + idx), k); unpack8(*(const u32x4*)(vl + idx), v);
            unpack8h(*(const u32x4*)(aa + idx), a); unpack8(*(const u32x4*)(gg + idx), g);
            float s = 0.f, dot = 0.f;
#pragma unroll
            for (int e = 0; e < 8; ++e) { s += yv[e]; dot += r[e] * k[e] * (1.0f + (a[e] - 1.0f) * ka[e]) * rk[e]; }
            s = sum8(s); dot = sum8(dot);
            const float mu = s * (1.0f / 64.0f);
            float q = 0.f;
#pragma unroll
            for (int e = 0; e < 8; ++e) { const float d = yv[e] - mu; q += d * d; }
            q = sum8(q);
            const float rs = rsqrtf(q * (1.0f / 64.0f) + 64e-5f);
#pragma unroll
            for (int e = 0; e < 8; ++e) yv[e] = (((yv[e] - mu) * rs) * lw[e] + lb[e] + dot * v[e]) * g[e];
            *(u32x4*)(y + idx) = pack8(yv);
        }
    }
}

__device__ __forceinline__ void conv_phase(const bf16_t* u, bf16_t* fin, const float* cw, const float* cb) {
    constexpr int STRIP = 32;
    const int items = 352 * (TH / STRIP), stride = (int)gridDim.x * 512;
    for (int it = (int)blockIdx.x * 512 + opaque_tid(); it < items; it += stride) {
        const int chunk = it % 352, strip = it / 352, n = chunk * 8, tok0 = strip * STRIP, t0 = tok0 & (SEQ - 1);
        float wg[3][8], wv[3][8], bg[8], bv[8];
#pragma unroll
        for (int j = 0; j < 3; ++j) {
            const f32x4 a0 = *(const f32x4*)(cw + j * 2 * DFF + n), a1 = *(const f32x4*)(cw + j * 2 * DFF + n + 4), b0 = *(const f32x4*)(cw + j * 2 * DFF + DFF + n), b1 = *(const f32x4*)(cw + j * 2 * DFF + DFF + n + 4);
#pragma unroll
            for (int e = 0; e < 4; ++e) { wg[j][e] = a0[e]; wg[j][4 + e] = a1[e]; wv[j][e] = b0[e]; wv[j][4 + e] = b1[e]; }
        }
        {
            const f32x4 a0 = *(const f32x4*)(cb + n), a1 = *(const f32x4*)(cb + n + 4), b0 = *(const f32x4*)(cb + DFF + n), b1 = *(const f32x4*)(cb + DFF + n + 4);
#pragma unroll
            for (int e = 0; e < 4; ++e) { bg[e] = a0[e]; bg[4 + e] = a1[e]; bv[e] = b0[e]; bv[4 + e] = b1[e]; }
        }
        float g2[8], v2[8], g1[8], v1[8];
        if (t0 >= 2) {
            unpack8(*(const u32x4*)(u + (size_t)(tok0 - 2) * (2 * DFF) + n), g2); unpack8(*(const u32x4*)(u + (size_t)(tok0 - 2) * (2 * DFF) + DFF + n), v2);
            unpack8(*(const u32x4*)(u + (size_t)(tok0 - 1) * (2 * DFF) + n), g1); unpack8(*(const u32x4*)(u + (size_t)(tok0 - 1) * (2 * DFF) + DFF + n), v1);
        } else {
#pragma unroll
            for (int e = 0; e < 8; ++e) { g2[e] = 0.f; v2[e] = 0.f; g1[e] = 0.f; v1[e] = 0.f; }
        }
#pragma unroll 4
        for (int i = 0; i < STRIP; ++i) {
            const size_t tok = (size_t)(tok0 + i);
            float g0[8], v0[8], o[8];
            unpack8(*(const u32x4*)(u + tok * (2 * DFF) + n), g0); unpack8(*(const u32x4*)(u + tok * (2 * DFF) + DFF + n), v0);
#pragma unroll
            for (int e = 0; e < 8; ++e) {
                const float x = bg[e] + wg[0][e] * g2[e] + wg[1][e] * g1[e] + wg[2][e] * g0[e];
                const float vv = bv[e] + wv[0][e] * v2[e] + wv[1][e] * v1[e] + wv[2][e] * v0[e];
                o[e] = x * sigmoidf_(1.5957691216f * (x + 0.044715f * x * x * x)) * vv;
                g2[e] = g1[e]; g1[e] = g0[e]; v2[e] = v1[e]; v1[e] = v0[e];
            }
            *(u32x4*)(fin + tok * DFF + n) = pack8(o);
        }
    }
}

#define XB_TMO      128
#define XB_XCNT(j)  (256  + 64 * (j))
#define XB_XSUB(j)  (1280 + 64 * (j))
#define XB_XGEN(j)  (2304 + 64 * (j))
#define XB_TOP      3328
#define XB_TOPGEN   3392
#define XCD_BAR_WORDS 3456
#define XB_SPIN_CAP (1u << 18)
__device__ __forceinline__ unsigned xb_ld(unsigned* p)              { return __hip_atomic_load(p, __ATOMIC_RELAXED, __HIP_MEMORY_SCOPE_AGENT); }
__device__ __forceinline__ unsigned xb_add(unsigned* p, unsigned v) { return __hip_atomic_fetch_add(p, v, __ATOMIC_RELAXED, __HIP_MEMORY_SCOPE_AGENT); }
__device__ __forceinline__ unsigned xb_xcc_id() { return (unsigned)__builtin_amdgcn_s_getreg((3 << 11) | 20) & 0xFu; }
#define XB_SPIN(cond, bar) do { unsigned _sp = 0; while (cond) { __builtin_amdgcn_s_sleep(1); \
    if ((++_sp & 255u) == 0u) { if (xb_ld(&(bar)[XB_TMO])) break; if (_sp > XB_SPIN_CAP) { atomicAdd(&(bar)[XB_TMO], 1u); break; } } } } while (0)
struct XcdBarrier { unsigned* bar; unsigned x; volatile LAS unsigned* st; };
__device__ __forceinline__ XcdBarrier xcd_barrier_post(unsigned* bar, volatile LAS unsigned* st) {
    XcdBarrier b; b.bar = bar; b.x = xb_xcc_id(); b.st = st;
    if (threadIdx.x == 0) (void)xb_add(&bar[XB_XCNT(b.x)], 1u);
    return b;
}
__device__ __forceinline__ void xcd_barrier_complete(unsigned* bar, unsigned x, unsigned& nloc, unsigned& nx) {
    const unsigned G = gridDim.x * gridDim.y * gridDim.z;
    unsigned sum, cnt, mine, sp = 0u;
    for (;;) {
        sum = 0u; cnt = 0u; mine = 0u;
#pragma unroll
        for (unsigned j = 0; j < 16; ++j) { const unsigned c = xb_ld(&bar[XB_XCNT(j)]); sum += c; cnt += (c > 0u) ? 1u : 0u; mine = (j == x) ? c : mine; }
        if (sum == G) break;
        __builtin_amdgcn_s_sleep(1);
        if ((++sp & 255u) == 0u) { if (xb_ld(&bar[XB_TMO])) break; if (sp > XB_SPIN_CAP) { atomicAdd(&bar[XB_TMO], 1u); break; } }
    }
    nloc = mine > 0u ? mine : 1u; nx = cnt > 0u ? cnt : 1u;
}
__device__ __forceinline__ void xcd_barrier(const XcdBarrier& b) {
    asm volatile("s_waitcnt vmcnt(0)" ::: "memory");
    __syncthreads();
    if (threadIdx.x == 0) {
        unsigned* bar = b.bar;
        __builtin_amdgcn_s_waitcnt(0);
        unsigned nloc = b.st[0], nx = b.st[1];
        if (nloc == 0u) { xcd_barrier_complete(bar, b.x, nloc, nx); b.st[0] = nloc; b.st[1] = nx; }
        const unsigned old = xb_add(&bar[XB_XSUB(b.x)], 1u);
        const unsigned gen = old / nloc;
        if (old + 1u == (gen + 1u) * nloc) {
            __builtin_amdgcn_fence(__ATOMIC_RELEASE, "agent");
            asm volatile("s_waitcnt vmcnt(0)" ::: "memory");
            const unsigned og = xb_add(&bar[XB_TOP], 1u);
            const unsigned tg = og / nx;
            if (og + 1u == (tg + 1u) * nx) xb_add(&bar[XB_TOPGEN], 1u);
            else XB_SPIN(xb_ld(&bar[XB_TOPGEN]) == tg, bar);
            __builtin_amdgcn_fence(__ATOMIC_ACQUIRE, "agent");
            xb_add(&bar[XB_XGEN(b.x)], 1u);
            asm volatile("s_waitcnt vmcnt(0)" ::: "memory");
        } else {
            XB_SPIN(xb_ld(&bar[XB_XGEN(b.x)]) == gen, bar);
            __builtin_amdgcn_fence(__ATOMIC_ACQUIRE, "agent");
            asm volatile("s_waitcnt vmcnt(0)" ::: "memory");
        }
    }
    __syncthreads();
}
constexpr size_t WS_BAR = 254 * MiB;

__global__ void __launch_bounds__(512, 2) fwd_megakernel(Params p) {
    extern __shared__ __attribute__((aligned(16))) unsigned char shm[];
    LAS unsigned char* lds = (LAS unsigned char*)shm;
    cg::grid_group grid = cg::this_grid();
    volatile LAS unsigned* xst = (volatile LAS unsigned*)(lds + DYN_LDS - 16);
    if (threadIdx.x == 0) { xst[0] = 0u; xst[1] = 0u; }
    if (blockIdx.x == 0) for (int i = threadIdx.x; i < XCD_BAR_WORDS; i += 512) ((unsigned*)(p.ws + WS_BAR))[i] = 0u;
    __syncthreads();
    XcdBarrier xbar; xbar.bar = (unsigned*)(p.ws + WS_BAR); xbar.x = xb_xcc_id(); xbar.st = xst;
    auto wsp = [&](size_t off) -> bf16_t* { size_t o = off; asm volatile("" : "+s"(o)); return (bf16_t*)(p.ws + o); };
#define HBUF wsp(WS_H)
#define POOLED wsp(WS_H)
#define AL wsp(WS_H + 8 * MiB)
#define VD wsp(WS_H + 12 * MiB)
#define ZP wsp(WS_ZP)
#define ZQ wsp(WS_ZQ)
#define ZR wsp(WS_ZR)
#define ZK wsp(WS_ZK)
#define ZV wsp(WS_ZV)
#define ZL wsp(WS_ZL)
#define GATES wsp(WS_GATES)
#define RL wsp(WS_RL)
#define KL wsp(WS_KL)
#define WT(off) ((const bf16_t*)wsp(WS_W + (off)))

    for (int l = 0; l < 2; ++l) {
        row_phase(p.mem, nullptr, nullptr, nullptr, p.mem_norm, wsp(WS_MEMN), 2048);
        cvt_mixer(lds, p, l);
        row_phase(l == 0 ? p.x : p.out, nullptr, nullptr, nullptr, p.norm_mix_pre + l * D, HBUF, TH);
        if (l == 0) { grid.sync(); if (threadIdx.x == 0) (void)xb_add(&xbar.bar[XB_XCNT(xbar.x)], 1u); }
        else xcd_barrier(xbar);
        for (int hb = 0; hb < 2; ++hb) {
            const size_t xoff = (size_t)hb * TH * D;
            const float* xin = (l == 0 ? p.x : p.out) + xoff;
            const size_t vf_off = WS_VFIRST + xoff * 2, vl_off = l == 0 ? vf_off : WS_VL;
            run_gemm(lds, HBUF, WT(W_IN), TH, INC, 1024, mk_epi(EM_Z, ZP, 0, p.gate_b + (size_t)l * 3 * D));
            if (hb == 0) {
                const int G = (int)gridDim.x, nz = (TH / 256) * (INC / 256), f0 = nz % G < G - 32 ? nz % G : 0;
                run_gemm_on(lds, wsp(WS_MEMN), WT(W_K), 2048, 512, 1024, mk_epi(EM_PLAIN, wsp(WS_KMEM), 512), f0, 16);
                run_gemm_on(lds, WT(W_V), wsp(WS_MEMN), 512, 2048, 1024, mk_epi(EM_PLAIN, wsp(WS_VT), 2048), f0 + 16, G - f0 - 16);
            }
            xcd_barrier(xbar);
            pool_phase(ZP, POOLED);
            prep_phase(ZR, ZL, p.mu_shift + (size_t)l * RWC, RL, KL, wsp(vl_off), AL, p.k_k + l * D, (float*)wsp(WS_KINV));
            attn_phase(lds, ZQ, wsp(WS_KMEM), wsp(WS_VT), hb);
            xcd_barrier(xbar);
            {
                const int G = (int)gridDim.x, nv = l > 0 ? G / 8 : 0, np = G / 4, nl = G - np - nv;
                run_gemm_on(lds, AL, WT(W_LORA), TH, 3072, 256, mk_epi(EM_LORA, ZR, 1024, p.w0 + l * D, p.a0 + l * D), 0, nl);
                run_gemm_on(lds, POOLED, WT(W_POOL), TH, 512, 512, mk_epi(EM_POOLW, ZP, 512, p.pool_b + l * 512, p.pool_scale + l * 512), nl, np);
                if (l > 0) run_gemm_on(lds, wsp(vl_off), WT(W_DOWN), TH, 256, 1024, mk_epi(EM_PLAIN, VD, 256), nl + np, nv);
            }
            xcd_barrier(xbar);
            if (l > 0) {
                run_gemm(lds, VD, WT(W_UP), TH, 1024, 256, mk_epi(EM_VUP, wsp(vl_off), 1024, p.v0 + (size_t)(l - 1) * D, nullptr, wsp(vf_off)));
                xcd_barrier(xbar);
            }
            scan_phase(lds, RL, KL, wsp(vl_off), ZR  , ZK  , (const float*)wsp(WS_KINV), HBUF, p.k_k + l * D, p.k_a + l * D);
            xcd_barrier(xbar);
            post_phase(HBUF, RL, KL, wsp(vl_off), ZK  , ZV  , p.k_a + l * D, p.r_k + l * D, p.ln_x_w + l * D, p.ln_x_b + l * D);
            xcd_barrier(xbar);
            {
                const int G = (int)gridDim.x, h0 = G / 2;
                run_gemm_on(lds, ZP, WT(W_PP), TH, 1024, 512, mk_epi(EM_MERGE, ZR  , 1024, nullptr, nullptr, GATES, 0, 0), 0, h0);
                run_gemm_on(lds, ZQ, WT(W_PM), TH, 1024, 512, mk_epi(EM_MERGE, ZR, 1024, nullptr, nullptr, GATES, 2, 1), 0, h0);
                run_gemm_on(lds, HBUF, WT(W_PR), TH, 1024, 1024, mk_epi(EM_MERGE, ZV  , 1024, nullptr, nullptr, GATES, 1, 0), h0, G - h0);
                xcd_barrier(xbar);
                run_gemm_on(lds, ZR, WT(W_O), TH, 1024, 1024, mk_epi(EM_PLAIN, ZK  , 1024), 0, h0);
                run_gemm_on(lds, ZV, WT(W_O), TH, 1024, 1024, mk_epi(EM_PLAIN, RL  , 1024), h0, G - h0);
                xcd_barrier(xbar);
            }
            row_phase(xin, ZK, p.norm_mix_post + l * D, p.out + xoff, nullptr, nullptr, TH, RL);
            if (hb == 0) row_phase((l == 0 ? p.x : p.out) + (size_t)TH * D, nullptr, nullptr, nullptr, p.norm_mix_pre + l * D, HBUF, TH);
            if (hb == 1) { cvt_ffn(lds, p, l); row_phase(p.out, nullptr, nullptr, nullptr, p.norm_ffn_pre + l * D, wsp(WS_H2), TH); }
            xcd_barrier(xbar);
        }
        for (int hb = 0; hb < 2; ++hb) {
            run_gemm(lds, wsp(WS_H2), WT(W_FU), TH, 2 * DFF, 1024, mk_epi(EM_PLAIN, wsp(WS_URAW), 2 * DFF));
            xcd_barrier(xbar);
            conv_phase(wsp(WS_URAW), wsp(WS_FIN) + (size_t)hb * TH * DFF, p.conv_w + (size_t)l * 3 * 2 * DFF, p.conv_b + (size_t)l * 2 * DFF);
            if (hb == 0) row_phase(p.out + (size_t)TH * D, nullptr, nullptr, nullptr, p.norm_ffn_pre + l * D, wsp(WS_H2), TH);
            xcd_barrier(xbar);
        }
        run_gemm(lds, wsp(WS_FIN), WT(W_FD), 2 * TH, 1024, DFF, mk_epi(EM_PLAIN, wsp(WS_F), 1024));
        xcd_barrier(xbar);
        row_phase(p.out, wsp(WS_F), p.norm_ffn_post + l * D, p.out, nullptr, nullptr, 2 * TH);
        if (l == 0) xcd_barrier(xbar);
    }
}

extern "C" void kernel_launch(void* const* d_in, const int* in_sizes, int n_in, void* d_out, int out_size, void* d_ws, size_t ws_size, hipStream_t stream) {
    static int grid_blocks = 0;
    if (!grid_blocks) {
        int dev = 0, cus = 0, per_cu = 0;
        hipGetDevice(&dev);
        hipDeviceGetAttribute(&cus, hipDeviceAttributeMultiprocessorCount, dev);
        hipFuncSetAttribute((const void*)fwd_megakernel, hipFuncAttributeMaxDynamicSharedMemorySize, DYN_LDS);
        hipOccupancyMaxActiveBlocksPerMultiprocessor(&per_cu, fwd_megakernel, 512, DYN_LDS);
        if (per_cu < 1) per_cu = 1;
        grid_blocks = cus * per_cu;
    }
    Params p{};
    const float** pp = (const float**)&p;
    for (int i = 0; i < 35; ++i) pp[i] = (const float*)d_in[i];
    p.out = (float*)d_out; p.ws = (unsigned char*)d_ws;
    void* args[] = {&p};
    hipError_t e = hipLaunchCooperativeKernel((void*)fwd_megakernel, dim3(grid_blocks), dim3(512), args, DYN_LDS, stream);
    if (e != hipSuccess) fprintf(stderr, "cooperative launch failed: %s (grid %d)\n", hipGetErrorString(e), grid_blocks);
}
```
